# Optimizing an MI355X kernel written in HIP

```python
import jax, jax.numpy as jnp
from jax import lax
import numpy as np

D_MODEL = 1024
BATCH = 16
SEQ = 2048
DEPTH = 2
DEC_BATCH = 128
DEC_SEQ = 8
PAST_LEN = 16384
PAGE_SIZE = 128

N_AB = (DEPTH + 1) // 2
N_C = DEPTH // 2
RMS_EPS = 1e-6
LN_EPS = 1e-5
RET_HEADS = 4
RET_DK = 128
RET_DV = 128
RET_WIDTH = RET_HEADS * RET_DV
RET_CHUNK = 128
ROPE_BASE = 10000.0
GM_GROUPS = 4
GM_GROUP_DIM = 128
GM_WIDTH = GM_GROUPS * GM_GROUP_DIM
GM_CHUNK = 128
AB_SPLITS = [RET_HEADS * RET_DK, 2 * RET_HEADS * RET_DK, 2 * RET_HEADS * RET_DK + RET_WIDTH,
             2 * RET_HEADS * RET_DK + 2 * RET_WIDTH, 2 * RET_HEADS * RET_DK + 2 * RET_WIDTH + GM_WIDTH]
AB_IN = 2 * RET_HEADS * RET_DK + 2 * RET_WIDTH + 2 * GM_WIDTH
AB_OUT = RET_WIDTH + GM_WIDTH
SWA_HEADS = 16
SWA_KV_HEADS = 2
SWA_HD = 64
SWA_GROUP = SWA_HEADS // SWA_KV_HEADS
WINDOW = 128
SWA_SPLITS = [SWA_HEADS * SWA_HD, (SWA_HEADS + SWA_KV_HEADS) * SWA_HD]
SWA_IN = (SWA_HEADS + 2 * SWA_KV_HEADS) * SWA_HD
SWA_OUT = SWA_HEADS * SWA_HD
D_FF = 4 * D_MODEL

kernel_name = "retnet_gmlp_swa_hybrid_step"


def rmsnorm(x, g):
    x32 = x.astype(jnp.float32)
    y = x32 * lax.rsqrt(jnp.mean(x32 * x32, axis=-1, keepdims=True) + RMS_EPS)
    return (y * g.astype(jnp.float32)).astype(x.dtype)


def rotary(x, pos):
    half = x.shape[-1] // 2
    inv = ROPE_BASE ** (-jnp.arange(half, dtype=jnp.float32) / half)
    ang = pos.astype(jnp.float32)[:, None] * inv[None, :]
    cos = jnp.cos(ang)[None, :, None, :]
    sin = jnp.sin(ang)[None, :, None, :]
    x32 = x.astype(jnp.float32)
    x1, x2 = x32[..., :half], x32[..., half:]
    return jnp.concatenate([x1 * cos - x2 * sin, x2 * cos + x1 * sin], axis=-1)


def retention(q, k, v, s0):
    B, L = q.shape[0], q.shape[1]
    C = RET_CHUNK if L % RET_CHUNK == 0 else L
    NC = L // C
    log_g = jnp.log1p(-jnp.exp2(-5.0 - jnp.arange(RET_HEADS, dtype=jnp.float32)))
    idx = jnp.arange(C, dtype=jnp.float32)
    diff = idx[:, None] - idx[None, :]
    decay_intra = jnp.where(diff[None] >= 0, jnp.exp(log_g[:, None, None] * jnp.maximum(diff, 0.0)[None]), 0.0)
    q_dec = jnp.exp(log_g[None, :] * (idx[:, None] + 1.0))
    k_dec = jnp.exp(log_g[None, :] * (C - 1.0 - idx[:, None]))
    chunk_dec = jnp.exp(log_g * C)
    qc = q.reshape(B, NC, C, RET_HEADS, RET_DK) * (RET_DK ** -0.5)
    kc = k.reshape(B, NC, C, RET_HEADS, RET_DK)
    vc = v.reshape(B, NC, C, RET_HEADS, RET_DV)
    scores = jnp.einsum('bnihd,bnjhd->bnhij', qc, kc) * decay_intra[None, None]
    intra = jnp.einsum('bnhij,bnjhv->bnihv', scores, vc)
    kv_chunk = jnp.einsum('bnjhd,bnjhv->nbhdv', kc * k_dec[None, None, :, :, None], vc)

    def step(s, kv):
        return s * chunk_dec[None, :, None, None] + kv, s

    s_final, s_prev = lax.scan(step, s0, kv_chunk)
    cross = jnp.einsum('bnihd,nbhdv->bnihv', qc * q_dec[None, None, :, :, None], s_prev)
    return (intra + cross).reshape(B, L, RET_HEADS, RET_DV), s_final


def gmlp_spatial(u, vn, w_s, b_s):
    B, L = vn.shape[0], vn.shape[1]
    pad = (-L) % GM_CHUNK
    vp = jnp.pad(vn, ((0, 0), (0, pad), (0, 0), (0, 0)))
    NC = (L + pad) // GM_CHUNK
    vc = vp.reshape(B, NC, GM_CHUNK, GM_GROUPS, GM_GROUP_DIM)
    causal = jnp.tril(jnp.ones((GM_CHUNK, GM_CHUNK), dtype=bool))
    w = jnp.where(causal[None], w_s, 0.0).astype(vn.dtype)
    mixed = jnp.einsum('gij,bnjgd->bnigd', w, vc) + b_s.T.astype(vn.dtype)[None, None, :, :, None]
    mixed = mixed.reshape(B, NC * GM_CHUNK, GM_GROUPS, GM_GROUP_DIM)[:, :L]
    return u * mixed


def mixer_ab(h, pos, s0, w_in, w_s, b_s, ln_g, ln_b, w_o):
    B, L, _ = h.shape
    z = h @ w_in
    q, k, v, g, u, gv = jnp.split(z, AB_SPLITS, axis=-1)
    q = rotary(q.reshape(B, L, RET_HEADS, RET_DK), pos)
    k = rotary(k.reshape(B, L, RET_HEADS, RET_DK), pos)
    v = v.reshape(B, L, RET_HEADS, RET_DV).astype(jnp.float32)
    o, s_new = retention(q, k, v, s0.astype(jnp.float32))
    o = o * lax.rsqrt(jnp.mean(o * o, axis=-1, keepdims=True) + RMS_EPS)
    o_ret = (jax.nn.silu(g.astype(jnp.float32)) * o.reshape(B, L, RET_WIDTH)).astype(h.dtype)
    u = jax.nn.gelu(u, approximate=False).reshape(B, L, GM_GROUPS, GM_GROUP_DIM)
    gv = jax.nn.gelu(gv, approximate=False).reshape(B, L, GM_GROUPS, GM_GROUP_DIM).astype(jnp.float32)
    mu = jnp.mean(gv, axis=-1, keepdims=True)
    var = jnp.mean(jnp.square(gv - mu), axis=-1, keepdims=True)
    gvn = ((gv - mu) * lax.rsqrt(var + LN_EPS) * ln_g.astype(jnp.float32) + ln_b.astype(jnp.float32)).astype(h.dtype)
    o_gm = gmlp_spatial(u, gvn, w_s, b_s).reshape(B, L, GM_WIDTH)
    y = jnp.concatenate([o_ret, o_gm], axis=-1) @ w_o
    return y, s_new.astype(s0.dtype), gvn.reshape(B, L, GM_WIDTH)


def swa_project(h, w_qkv, b_qkv):
    B, L, _ = h.shape
    z = h @ w_qkv + b_qkv
    q, k, v = jnp.split(z, SWA_SPLITS, axis=-1)
    q = q.reshape(B, L, SWA_KV_HEADS, SWA_GROUP, SWA_HD)
    k = k.reshape(B, L, SWA_KV_HEADS, SWA_HD)
    v = v.reshape(B, L, SWA_KV_HEADS, SWA_HD)
    return q, k, v


def sink_softmax(scores, mask, sinks):
    s = jnp.where(mask, scores, -jnp.inf)
    sink = sinks.astype(jnp.float32).reshape(SWA_KV_HEADS, SWA_GROUP)[:, :, None, None]
    m = jnp.maximum(jnp.max(s, axis=-1, keepdims=True), sink)
    p = jnp.exp(s - m)
    return p / (jnp.sum(p, axis=-1, keepdims=True) + jnp.exp(sink - m))


def swa_prompt(h, w_qkv, b_qkv, sinks, w_o, b_o):
    B, S, _ = h.shape
    q, k, v = swa_project(h, w_qkv, b_qkv)
    NB = S // WINDOW
    qb = q.reshape(B, NB, WINDOW, SWA_KV_HEADS, SWA_GROUP, SWA_HD).astype(jnp.float32)
    kb = k.reshape(B, NB, WINDOW, SWA_KV_HEADS, SWA_HD).astype(jnp.float32)
    vb = v.reshape(B, NB, WINDOW, SWA_KV_HEADS, SWA_HD).astype(jnp.float32)
    k_band = jnp.concatenate([jnp.pad(kb, ((0, 0), (1, 0), (0, 0), (0, 0), (0, 0)))[:, :-1], kb], axis=2)
    v_band = jnp.concatenate([jnp.pad(vb, ((0, 0), (1, 0), (0, 0), (0, 0), (0, 0)))[:, :-1], vb], axis=2)
    scores = jnp.einsum('bnikgd,bnjkd->bnkgij', qb, k_band) * (SWA_HD ** -0.5)
    i = jnp.arange(WINDOW)[:, None]
    j = jnp.arange(2 * WINDOW)[None, :]
    rel = i + WINDOW - j
    band = (rel >= 0) & (rel <= WINDOW)
    has_prev = jnp.arange(NB)[:, None, None] > 0
    mask = band[None] & (has_prev | (j >= WINDOW)[None])
    p = sink_softmax(scores, mask[None, :, None, None], sinks)
    o = jnp.einsum('bnkgij,bnjkd->bnikgd', p, v_band).reshape(B, S, SWA_OUT).astype(h.dtype)
    return o @ w_o + b_o, k[:, -WINDOW:], v[:, -WINDOW:]


def swa_sample(h, cache_k, cache_v, w_qkv, b_qkv, sinks, w_o, b_o):
    B, L, _ = h.shape
    W = cache_k.shape[1]
    q, k, v = swa_project(h, w_qkv, b_qkv)
    k_all = jnp.concatenate([cache_k.astype(k.dtype), k], axis=1)
    v_all = jnp.concatenate([cache_v.astype(v.dtype), v], axis=1)
    scores = jnp.einsum('bikgd,bjkd->bkgij', q.astype(jnp.float32), k_all.astype(jnp.float32)) * (SWA_HD ** -0.5)
    rel = W + jnp.arange(L)[:, None] - jnp.arange(W + L)[None, :]
    mask = (rel >= 0) & (rel <= WINDOW)
    p = sink_softmax(scores, mask[None, None, None], sinks)
    o = jnp.einsum('bkgij,bjkd->bikgd', p, v_all.astype(jnp.float32)).reshape(B, L, SWA_OUT).astype(h.dtype)
    return o @ w_o + b_o, k_all[:, -WINDOW:], v_all[:, -WINDOW:]


def sqrelu_mlp(h, w_up, w_down):
    return jnp.square(jax.nn.relu(h @ w_up)) @ w_down


def setup_inputs(seed: int = 0) -> dict:
    key = jax.random.key(seed)
    ks = jax.random.split(key, 24)
    f32 = jnp.float32
    nrm = lambda k, shape, scale: jax.random.normal(k, shape, f32) * scale
    return {
        "x_prompt": nrm(ks[0], (BATCH, SEQ, D_MODEL), 1.0),
        "x_sample": nrm(ks[1], (DEC_BATCH, DEC_SEQ, D_MODEL), 1.0),
        "state_ret": nrm(ks[2], (N_AB, DEC_BATCH, RET_HEADS, RET_DK, RET_DV), 1.0),
        "cache_swa_k": nrm(ks[3], (N_C, DEC_BATCH, WINDOW, SWA_KV_HEADS, SWA_HD), 1.0),
        "cache_swa_v": nrm(ks[4], (N_C, DEC_BATCH, WINDOW, SWA_KV_HEADS, SWA_HD), 1.0),
        "norm_mix": 1.0 + nrm(ks[5], (DEPTH, D_MODEL), 0.05),
        "norm_mlp": 1.0 + nrm(ks[6], (DEPTH, D_MODEL), 0.05),
        "norm_final": 1.0 + nrm(ks[7], (D_MODEL,), 0.05),
        "ab_w_in": nrm(ks[8], (N_AB, D_MODEL, AB_IN), D_MODEL ** -0.5),
        "ab_w_s": nrm(ks[9], (N_AB, GM_GROUPS, GM_CHUNK, GM_CHUNK), GM_CHUNK ** -0.5),
        "ab_b_s": 1.0 + nrm(ks[10], (N_AB, GM_GROUPS, GM_CHUNK), 0.1),
        "ab_ln_g": 1.0 + nrm(ks[11], (N_AB, GM_GROUPS, GM_GROUP_DIM), 0.05),
        "ab_ln_b": nrm(ks[12], (N_AB, GM_GROUPS, GM_GROUP_DIM), 0.05),
        "ab_w_o": nrm(ks[13], (N_AB, AB_OUT, D_MODEL), AB_OUT ** -0.5),
        "swa_w_qkv": nrm(ks[14], (N_C, D_MODEL, SWA_IN), D_MODEL ** -0.5),
        "swa_b_qkv": nrm(ks[15], (N_C, SWA_IN), 0.02),
        "swa_sinks": nrm(ks[16], (N_C, SWA_HEADS), 0.5),
        "swa_w_o": nrm(ks[17], (N_C, SWA_OUT, D_MODEL), SWA_OUT ** -0.5),
        "swa_b_o": nrm(ks[18], (N_C, D_MODEL), 0.02),
        "mlp_w_up": nrm(ks[19], (DEPTH, D_MODEL, D_FF), D_MODEL ** -0.5),
        "mlp_w_down": nrm(ks[20], (DEPTH, D_FF, D_MODEL), D_FF ** -0.5),
    }


def reference(x_prompt, x_sample, state_ret, cache_swa_k, cache_swa_v,
              norm_mix, norm_mlp, norm_final,
              ab_w_in, ab_w_s, ab_b_s, ab_ln_g, ab_ln_b, ab_w_o,
              swa_w_qkv, swa_b_qkv, swa_sinks, swa_w_o, swa_b_o,
              mlp_w_up, mlp_w_down):
    B, S, _ = x_prompt.shape
    L = x_sample.shape[1]
    pos_p = jnp.arange(S, dtype=jnp.int32)
    pos_s = PAST_LEN + jnp.arange(L, dtype=jnp.int32)
    hp, hs = x_prompt, x_sample
    ret_p, ret_s, gm_s, kp, vp, ksm, vsm = [], [], [], [], [], [], []
    for l in range(DEPTH):
        hn_p = rmsnorm(hp, norm_mix[l])
        hn_s = rmsnorm(hs, norm_mix[l])
        if l % 2 == 0:
            a = l // 2
            s_zero = jnp.zeros((B, RET_HEADS, RET_DK, RET_DV), dtype=state_ret.dtype)
            yp, sp, _ = mixer_ab(hn_p, pos_p, s_zero, ab_w_in[a], ab_w_s[a], ab_b_s[a], ab_ln_g[a], ab_ln_b[a], ab_w_o[a])
            ys, ss, gvs = mixer_ab(hn_s, pos_s, state_ret[a], ab_w_in[a], ab_w_s[a], ab_b_s[a], ab_ln_g[a], ab_ln_b[a], ab_w_o[a])
            ret_p.append(sp)
            ret_s.append(ss)
            gm_s.append(gvs)
        else:
            c = l // 2
            yp, kpn, vpn = swa_prompt(hn_p, swa_w_qkv[c], swa_b_qkv[c], swa_sinks[c], swa_w_o[c], swa_b_o[c])
            ys, ksn, vsn = swa_sample(hn_s, cache_swa_k[c], cache_swa_v[c], swa_w_qkv[c], swa_b_qkv[c], swa_sinks[c], swa_w_o[c], swa_b_o[c])
            kp.append(kpn)
            vp.append(vpn)
            ksm.append(ksn)
            vsm.append(vsn)
        hp = hp + yp
        hs = hs + ys
        hp = hp + sqrelu_mlp(rmsnorm(hp, norm_mlp[l]), mlp_w_up[l], mlp_w_down[l])
        hs = hs + sqrelu_mlp(rmsnorm(hs, norm_mlp[l]), mlp_w_up[l], mlp_w_down[l])
    y_prompt = rmsnorm(hp, norm_final)
    y_sample = rmsnorm(hs, norm_final)
    return (y_prompt, y_sample, jnp.stack(ret_p), jnp.stack(ret_s), jnp.stack(gm_s),
            jnp.stack(kp), jnp.stack(vp), jnp.stack(ksm), jnp.stack(vsm))
```

```cpp
#include <hip/hip_runtime.h>
#include <cstdio>
#include <cstdint>
namespace pg8 {
#define PG8_LAS __attribute__((address_space(3)))
typedef unsigned short bf16_t;
typedef short bf16x8 __attribute__((ext_vector_type(8)));
typedef float f32x4 __attribute__((ext_vector_type(4)));
typedef unsigned u32x4 __attribute__((ext_vector_type(4)));
constexpr int BM = 256, BK = 64, HALF = 128, HTB = HALF * BK * 2  , STAGE_BYTES = 8 * HTB, NXCD = 8, WGM = 8;

__host__ __device__ __forceinline__ int lds_byte(int r, int c) { const int st = (r >> 4) * 2 + (c >> 5), rr = r & 15, cc = c & 31, ob = rr * 64 + cc * 2; return st * 1024 + (ob ^ (((ob >> 9) & 1) << 5)); }
__host__ __device__ __forceinline__ void stage_rc(int b, int& R, int& C) { const int st = b / 1024, sb = b % 1024, swz = sb ^ (((sb >> 9) & 1) << 5); R = (st >> 1) * 16 + swz / 64; C = (st & 1) * 32 + (swz % 64) / 2; }
__host__ __device__ __forceinline__ int perm32(int rho) { const int n = rho >> 4, i = rho & 15; return 8 * (i >> 2) + 4 * n + (i & 3); }

struct Unit { int pm, pn; };
struct Gemm { const bf16_t* A; const bf16_t* Bt; int M, N, K; };

struct StaticOrder {
    int nM, nN, nwg, G, c;
    __host__ __device__ void init(int M, int N, int G_, int c_) { nM = M / BM; nN = N / BM; nwg = nM * nN; G = G_; c = c_; }
    __host__ __device__ bool next(int i, Unit& u) const {
        const long L = (long)i * G + c; if (L >= nwg) return false;
        int wgid = (int)L; { const int q = nwg / NXCD, r = nwg % NXCD, xcd = wgid % NXCD, off = wgid / NXCD; wgid = (xcd < r ? xcd * (q + 1) : r * (q + 1) + (xcd - r) * q) + off; }
        const int nig = WGM * nN, gid = wgid / nig, fm = gid * WGM, gsz = (nM - fm) < WGM ? (nM - fm) : WGM;
        u.pm = fm + ((wgid % nig) % gsz); u.pn = (wgid % nig) / gsz; return true;
    }
    __device__ __forceinline__ void a_ready(const Unit&) const {}
    __device__ __forceinline__ void done(const Unit&) const {}
};

__device__ __forceinline__ unsigned cvt_pk_bf16(float lo, float hi) { unsigned r; asm volatile("v_cvt_pk_bf16_f32 %0, %1, %2" : "=v"(r) : "v"(lo), "v"(hi)); return r; }
typedef float f32x2 __attribute__((ext_vector_type(2)));
__device__ __forceinline__ f32x2 gelu_pk(f32x2 v) {
    const f32x2 av = __builtin_elementwise_abs(v), d = av * 0.2316418882f + 1.0f;
    f32x2 t; t.x = __builtin_amdgcn_rcpf(d.x); t.y = __builtin_amdgcn_rcpf(d.y);
    f32x2 q = t * 0.5307027145f + (-0.7265760135f); q = q * t + 0.7107068705f; q = q * t + (-0.142248368f); q = q * t + 0.127414796f; q = q * t;
    const f32x2 s = (v * v) * (-0.72134752044f);
    f32x2 e; e.x = __builtin_amdgcn_exp2f(s.x); e.y = __builtin_amdgcn_exp2f(s.y);
    const f32x2 m = v * (q * e), r = v - m;
    f32x2 o; o.x = v.x < 0.f ? m.x : r.x; o.y = v.y < 0.f ? m.y : r.y; return o;
}

template <class Epi, class Sched, bool ALIGN_EPI = false, bool SP2 = false>
__device__ __forceinline__ void gemm_phase(PG8_LAS unsigned char* lds, const Gemm g, const Sched& S, const Epi& E) {
    const int tid = threadIdx.x, wid = __builtin_amdgcn_readfirstlane(tid >> 6), lane = tid & 63, wr = wid >> 2, wc = wid & 3, fr = lane & 15, fq = lane >> 4;
    const int K = g.K, nt = K / BK;
    unsigned voffA[2], voffB[2];
#pragma unroll
    for (int i = 0; i < 2; ++i) { int R, C; stage_rc(tid * 16 + i * 8192, R, C); const int Rb = Epi::PERM ? ((R & ~31) + perm32(R & 31)) : R;
        voffA[i] = (unsigned)(R * K + C) * 2u; voffB[i] = (unsigned)(Rb * K + C) * 2u; }
    const size_t kstep = (size_t)(BK * 2);
    const size_t hstep = (size_t)HALF * K * 2;
    const size_t tstep = 2 * hstep;
    const unsigned ldsw = (unsigned)wid * 1024u;
    const int aoff = lds_byte(wr * 64 + fr, fq * 8), boff = lds_byte(wc * 32 + fr, fq * 8);
#define PG8_SA(b, h) (((b) * 2 + (h)) * HTB)
#define PG8_SB(b, h) ((4 + (b) * 2 + (h)) * HTB)
#define PG8_STAGE(bufoff, gbase, voff) do { _Pragma("unroll") for (int _i = 0; _i < 2; ++_i) \
        __builtin_amdgcn_global_load_lds((const unsigned*)((const char*)(gbase) + (voff)[_i]), (PG8_LAS unsigned*)(lds + (bufoff) + ldsw + _i * 8192), 16, 0, 0); } while (0)
#define PG8_LDA(dst, b, h) do { _Pragma("unroll") for (int m = 0; m < 4; ++m) _Pragma("unroll") for (int k = 0; k < 2; ++k) dst[m][k] = *(const PG8_LAS bf16x8*)(lds + PG8_SA(b, h) + aoff + m * 2048 + k * 1024); } while (0)
#define PG8_LDB(dst, b, h) do { _Pragma("unroll") for (int n = 0; n < 2; ++n) _Pragma("unroll") for (int k = 0; k < 2; ++k) dst[n][k] = *(const PG8_LAS bf16x8*)(lds + PG8_SB(b, h) + boff + n * 2048 + k * 1024); } while (0)
#define PG8_MMA(ai, bj, At, Bt) do { __builtin_amdgcn_s_setprio(1); _Pragma("unroll") for (int m = 0; m < 4; ++m) _Pragma("unroll") for (int n = 0; n < 2; ++n) _Pragma("unroll") for (int k = 0; k < 2; ++k) \
        acc[ai][bj][m][n] = __builtin_amdgcn_mfma_f32_16x16x32_bf16(Bt[n][k], At[m][k], acc[ai][bj][m][n], 0, 0, 0); __builtin_amdgcn_s_setprio(0); } while (0)
#define PG8_WAIT_V(n) asm volatile("s_waitcnt vmcnt(" #n ")" ::: "memory")
#define PG8_WAIT_L(n) asm volatile("s_waitcnt lgkmcnt(" #n ")" ::: "memory")
#define PG8_BAR __builtin_amdgcn_s_barrier()
#define PG8_SCHED __builtin_amdgcn_sched_barrier(0)
    Unit cur, nxt; int ui = 0;
    if (!S.next(0, cur)) return;
    f32x4 acc[2][2][4][2];
#pragma unroll
    for (int a = 0; a < 2; ++a)
#pragma unroll
        for (int b = 0; b < 2; ++b)
#pragma unroll
            for (int m = 0; m < 4; ++m)
#pragma unroll
                for (int n = 0; n < 2; ++n) acc[a][b][m][n] = (f32x4){0.f, 0.f, 0.f, 0.f};
    bf16x8 At[4][2], B0[2][2], B1[2][2];
    const char* cA = (const char*)g.A + (size_t)cur.pm * tstep; const char* cB = (const char*)g.Bt + (size_t)cur.pn * tstep;
    S.a_ready(cur);
    if constexpr (SP2) {
        PG8_STAGE(PG8_SB(0, 0), cB, voffB); PG8_STAGE(PG8_SB(0, 1), cB + hstep, voffB); PG8_STAGE(PG8_SA(0, 0), cA, voffA); PG8_STAGE(PG8_SA(0, 1), cA + hstep, voffA);
        if (wr == 1) PG8_BAR;
        PG8_WAIT_V(2); PG8_BAR;
        PG8_STAGE(PG8_SB(1, 0), cB + kstep, voffB); PG8_STAGE(PG8_SA(1, 0), cA + kstep, voffA); PG8_STAGE(PG8_SB(1, 1), cB + hstep + kstep, voffB);
        PG8_WAIT_V(6); PG8_BAR;
    } else {
        PG8_STAGE(PG8_SB(0, 0), cB, voffB); PG8_STAGE(PG8_SA(0, 0), cA, voffA); PG8_STAGE(PG8_SB(0, 1), cB + hstep, voffB); PG8_STAGE(PG8_SA(0, 1), cA + hstep, voffA);
        if (wr == 1) PG8_BAR;
        PG8_WAIT_V(4); PG8_BAR;
        PG8_STAGE(PG8_SB(1, 0), cB + kstep, voffB); PG8_STAGE(PG8_SA(1, 0), cA + kstep, voffA); PG8_STAGE(PG8_SB(1, 1), cB + hstep + kstep, voffB);
        PG8_WAIT_V(6); PG8_BAR;
    }
    for (;;) {
        const bool has_next = S.next(ui + 1, nxt);
        const char* nA = has_next ? (const char*)g.A + (size_t)nxt.pm * tstep : cA; const char* nB = has_next ? (const char*)g.Bt + (size_t)nxt.pn * tstep : cB;
        for (int t = 0; t < nt; t += 2) {
            const bool last = (t == nt - 2);
            const char* a1 = cA + (size_t)(t + 1) * kstep;
            const char* a2 = last ? nA : cA + (size_t)(t + 2) * kstep; const char* b2 = last ? nB : cB + (size_t)(t + 2) * kstep;
            const char* a3 = a2 + kstep; const char* b3 = b2 + kstep;
            if (last && has_next) S.a_ready(nxt);
            if constexpr (SP2) {
            PG8_LDB(B0, 0, 0); PG8_LDB(B1, 0, 1); PG8_SCHED; PG8_LDA(At, 0, 0); PG8_STAGE(PG8_SA(1, 1), a1 + hstep, voffA);
            PG8_WAIT_V(8); PG8_WAIT_L(0); PG8_BAR; PG8_MMA(0, 0, At, B0); PG8_MMA(0, 1, At, B1); PG8_BAR; PG8_SCHED;
            PG8_LDA(At, 0, 1); PG8_STAGE(PG8_SB(0, 0), b2, voffB); PG8_STAGE(PG8_SB(0, 1), b2 + hstep, voffB); PG8_STAGE(PG8_SA(0, 0), a2, voffA);
            PG8_WAIT_V(8); PG8_WAIT_L(0); PG8_BAR; PG8_MMA(1, 0, At, B0); PG8_MMA(1, 1, At, B1); PG8_BAR; PG8_SCHED;
            PG8_LDB(B0, 1, 0); PG8_LDB(B1, 1, 1); PG8_SCHED; PG8_LDA(At, 1, 0); PG8_STAGE(PG8_SA(0, 1), a2 + hstep, voffA);
            PG8_WAIT_V(8); PG8_WAIT_L(0); PG8_BAR; PG8_MMA(0, 0, At, B0); PG8_MMA(0, 1, At, B1); PG8_BAR; PG8_SCHED;
            PG8_LDA(At, 1, 1); PG8_STAGE(PG8_SB(1, 0), b3, voffB); PG8_STAGE(PG8_SB(1, 1), b3 + hstep, voffB); PG8_STAGE(PG8_SA(1, 0), a3, voffA);
            PG8_WAIT_V(8); PG8_WAIT_L(0); PG8_BAR; PG8_MMA(1, 0, At, B0); PG8_MMA(1, 1, At, B1); PG8_BAR; PG8_SCHED;
            } else {
            PG8_LDB(B0, 0, 0); PG8_SCHED; PG8_LDA(At, 0, 0); PG8_STAGE(PG8_SA(1, 1), a1 + hstep, voffA);
            PG8_WAIT_L(8); PG8_BAR; PG8_WAIT_L(0); PG8_MMA(0, 0, At, B0); PG8_BAR; PG8_SCHED;
            PG8_LDB(B1, 0, 1); PG8_STAGE(PG8_SB(0, 0), b2, voffB);
            PG8_BAR; PG8_WAIT_L(0); PG8_MMA(0, 1, At, B1); PG8_BAR;
            PG8_LDA(At, 0, 1); PG8_STAGE(PG8_SA(0, 0), a2, voffA);
            PG8_BAR; PG8_WAIT_L(0); PG8_MMA(1, 0, At, B0); PG8_BAR; PG8_SCHED;
            PG8_STAGE(PG8_SB(0, 1), b2 + hstep, voffB);
            PG8_WAIT_V(6); PG8_BAR; PG8_MMA(1, 1, At, B1); PG8_BAR;
            PG8_LDB(B0, 1, 0); PG8_SCHED; PG8_LDA(At, 1, 0); PG8_STAGE(PG8_SA(0, 1), a2 + hstep, voffA);
            PG8_WAIT_L(8); PG8_BAR; PG8_WAIT_L(0); PG8_MMA(0, 0, At, B0); PG8_BAR; PG8_SCHED;
            PG8_LDB(B1, 1, 1); PG8_STAGE(PG8_SB(1, 0), b3, voffB);
            PG8_BAR; PG8_WAIT_L(0); PG8_MMA(0, 1, At, B1); PG8_BAR;
            PG8_LDA(At, 1, 1); PG8_STAGE(PG8_SA(1, 0), a3, voffA);
            PG8_BAR; PG8_WAIT_L(0); PG8_MMA(1, 0, At, B0); PG8_BAR; PG8_SCHED;
            PG8_STAGE(PG8_SB(1, 1), b3 + hstep, voffB);
            PG8_WAIT_V(6); PG8_BAR; PG8_MMA(1, 1, At, B1); PG8_BAR;
            }
        }
        if constexpr (ALIGN_EPI) { if (wr == 0) PG8_BAR; }
        if constexpr (!Epi::AFTER_DRAIN) { E(acc, cur, wr, wc, fr, fq); S.done(cur); }
        if (!has_next) break;
#pragma unroll
        for (int a = 0; a < 2; ++a)
#pragma unroll
            for (int b = 0; b < 2; ++b)
#pragma unroll
                for (int m = 0; m < 4; ++m)
#pragma unroll
                    for (int n = 0; n < 2; ++n) acc[a][b][m][n] = (f32x4){0.f, 0.f, 0.f, 0.f};
        cur = nxt; cA = nA; cB = nB; ++ui;
        if constexpr (ALIGN_EPI) { if (wr == 1) PG8_BAR; }
    }
    PG8_WAIT_V(0);
    if constexpr (!ALIGN_EPI) { if (wr == 0) PG8_BAR; }
    PG8_BAR;
    if constexpr (Epi::AFTER_DRAIN) { E.fused(acc, cur, wr, wc, fr, fq, lds, wid, lane); S.done(cur); }
#undef PG8_SA
#undef PG8_SB
#undef PG8_STAGE
#undef PG8_LDA
#undef PG8_LDB
#undef PG8_MMA
#undef PG8_WAIT_V
#undef PG8_WAIT_L
#undef PG8_BAR
#undef PG8_SCHED
}
}

namespace pg8 {
constexpr int MP_ROWS = 32768;
typedef unsigned u32x2 __attribute__((ext_vector_type(2)));
__device__ __forceinline__ unsigned pkbf(float lo, float hi) { typedef float f2_t __attribute__((ext_vector_type(2))); typedef __bf16 b2_t __attribute__((ext_vector_type(2))); f2_t v = {lo, hi}; b2_t b = __builtin_convertvector(v, b2_t); return __builtin_bit_cast(unsigned, b); }
__device__ __forceinline__ u32x4 pk8(f32x4 a, f32x4 b) { u32x4 w; w.x = pkbf(a[0], a[1]); w.y = pkbf(a[2], a[3]); w.z = pkbf(b[0], b[1]); w.w = pkbf(b[2], b[3]); return w; }
__device__ __forceinline__ float silu_f(float x) { return x * __builtin_amdgcn_rcpf(1.0f + __builtin_amdgcn_exp2f(-1.4426950408889634f * x)); }

struct EpiAB {
    static constexpr bool PERM = true, AFTER_DRAIN = false;
    bf16_t* Z; const float* rowss; const float* ropec; const float* ropes;
    __device__ __forceinline__ void operator()(const f32x4 (&acc)[2][2][4][2], const Unit& u, int wr, int wc, int fr, int fq) const {
        const int pn = u.pn;
#pragma unroll
        for (int ai = 0; ai < 2; ++ai)
#pragma unroll
            for (int m = 0; m < 4; ++m) {
                const int r = u.pm * BM + ai * HALF + wr * 64 + m * 16 + fr;
                const float rstd = __builtin_amdgcn_rsqf(rowss[r] * (1.0f / 1024.0f) + 1e-6f);
                bf16_t* zrow = Z + (size_t)r * 3072 + pn * 256;
                if (pn < 4) {
                    const bool prompt = r < MP_ROWS; const int ic = prompt ? (r & 127) : (r & 7); const int trow = prompt ? (r & 2047) : 2048 + (r & 7);
                    const int d0 = 16 * wc + 4 * fq;
                    const f32x4 cs = *(const f32x4*)(ropec + trow * 64 + d0), sn = *(const f32x4*)(ropes + trow * 64 + d0);
#pragma unroll
                    for (int bj = 0; bj < 2; ++bj) {
                        const int head = (pn & 1) * 2 + bj;
                        const float l2g = head == 0 ? -0.04580368961312479f : head == 1 ? -0.02272007650008353f : head == 2 ? -0.011315313227834146f : -0.005646563141142063f;
                        const float e = (float)(ic + 1) * l2g;
                        const float sc = rstd * (pn < 2 ? __builtin_amdgcn_exp2f(e) * 0.08838834764831845f : __builtin_amdgcn_exp2f(-e));
                        const f32x4 x1 = acc[ai][bj][m][0] * sc, x2 = acc[ai][bj][m][1] * sc;
                        const f32x4 o1 = x1 * cs - x2 * sn, o2 = x2 * cs + x1 * sn;
                        u32x2 w1, w2; w1.x = pkbf(o1[0], o1[1]); w1.y = pkbf(o1[2], o1[3]); w2.x = pkbf(o2[0], o2[1]); w2.y = pkbf(o2[2], o2[3]);
                        *(u32x2*)(zrow + bj * HALF + d0) = w1; *(u32x2*)(zrow + bj * HALF + 64 + d0) = w2;
                    }
                } else {
#pragma unroll
                    for (int bj = 0; bj < 2; ++bj) {
                        f32x4 v0 = acc[ai][bj][m][0] * rstd, v1 = acc[ai][bj][m][1] * rstd;
                        if (pn >= 8) { f32x2 a = gelu_pk((f32x2){v0[0], v0[1]}), b = gelu_pk((f32x2){v0[2], v0[3]}), c = gelu_pk((f32x2){v1[0], v1[1]}), d = gelu_pk((f32x2){v1[2], v1[3]});
                            v0 = (f32x4){a.x, a.y, b.x, b.y}; v1 = (f32x4){c.x, c.y, d.x, d.y}; }
                        else if (pn >= 6) { v0 = (f32x4){silu_f(v0[0]), silu_f(v0[1]), silu_f(v0[2]), silu_f(v0[3])}; v1 = (f32x4){silu_f(v1[0]), silu_f(v1[1]), silu_f(v1[2]), silu_f(v1[3])}; }
                        *(u32x4*)(zrow + bj * HALF + wc * 32 + 8 * fq) = pk8(v0, v1);
                    }
                }
                asm volatile("" ::: "memory");
            }
    }
};
struct EpiRes {
    static constexpr bool PERM = true, AFTER_DRAIN = false;
    const float* base_p; const float* base_s; float* out; bf16_t* hb; float* rowss_out; const float* bias;
    __device__ __forceinline__ void operator()(const f32x4 (&acc)[2][2][4][2], const Unit& u, int wr, int wc, int fr, int fq) const {
        const int cb = u.pn * BM + wc * 32 + 8 * fq;
#pragma unroll
        for (int ai = 0; ai < 2; ++ai)
#pragma unroll
            for (int m = 0; m < 4; ++m) {
                const int r = u.pm * BM + ai * HALF + wr * 64 + m * 16 + fr;
                const float* bp = r < MP_ROWS ? base_p + (size_t)r * 1024 : base_s + (size_t)(r - MP_ROWS) * 1024;
                float* op = out + (size_t)r * 1024; float ss = 0.f;
#pragma unroll
                for (int bj = 0; bj < 2; ++bj) {
                    const int col = cb + bj * HALF;
                    f32x4 v0 = acc[ai][bj][m][0] + *(const f32x4*)(bp + col), v1 = acc[ai][bj][m][1] + *(const f32x4*)(bp + col + 4);
                    if (bias) { v0 += *(const f32x4*)(bias + col); v1 += *(const f32x4*)(bias + col + 4); }
                    *(f32x4*)(op + col) = v0; *(f32x4*)(op + col + 4) = v1;
                    if (hb) *(u32x4*)(hb + (size_t)r * 1024 + col) = pk8(v0, v1);
                    ss += (v0[0] * v0[0] + v0[1] * v0[1]) + (v0[2] * v0[2] + v0[3] * v0[3]) + (v1[0] * v1[0] + v1[1] * v1[1]) + (v1[2] * v1[2] + v1[3] * v1[3]);
                }
                ss += __shfl_xor(ss, 16); ss += __shfl_xor(ss, 32);
                if (fq == 0) atomicAdd(rowss_out + r, ss);
                asm volatile("" ::: "memory");
            }
    }
};
struct EpiUp {
    static constexpr bool PERM = true, AFTER_DRAIN = false;
    bf16_t* O; const float* rowss;
    __device__ __forceinline__ void operator()(const f32x4 (&acc)[2][2][4][2], const Unit& u, int wr, int wc, int fr, int fq) const {
        const int cb = u.pn * BM + wc * 32 + 8 * fq;
#pragma unroll
        for (int ai = 0; ai < 2; ++ai)
#pragma unroll
            for (int m = 0; m < 4; ++m) {
                const int r = u.pm * BM + ai * HALF + wr * 64 + m * 16 + fr;
                const float rstd = __builtin_amdgcn_rsqf(rowss[r] * (1.0f / 1024.0f) + 1e-6f);
#pragma unroll
                for (int bj = 0; bj < 2; ++bj) {
                    f32x4 v0 = acc[ai][bj][m][0] * rstd, v1 = acc[ai][bj][m][1] * rstd;
#pragma unroll
                    for (int e = 0; e < 4; ++e) { const float a = fmaxf(v0[e], 0.f), b = fmaxf(v1[e], 0.f); v0[e] = a * a; v1[e] = b * b; }
                    *(u32x4*)(O + (size_t)r * 4096 + cb + bj * HALF) = pk8(v0, v1);
                }
                asm volatile("" ::: "memory");
            }
    }
};
struct EpiQKV {
    static constexpr bool PERM = true, AFTER_DRAIN = false;
    bf16_t* O; const float* rowss; const float* bias; float* ckp; float* cvp; float* cks; float* cvs;
    __device__ __forceinline__ void operator()(const f32x4 (&acc)[2][2][4][2], const Unit& u, int wr, int wc, int fr, int fq) const {
        const int pn = u.pn, cb = pn * BM + wc * 32 + 8 * fq; const float qs = pn < 4 ? 0.125f : 1.0f;
#pragma unroll
        for (int ai = 0; ai < 2; ++ai)
#pragma unroll
            for (int m = 0; m < 4; ++m) {
                const int r = u.pm * BM + ai * HALF + wr * 64 + m * 16 + fr;
                const float rstd = __builtin_amdgcn_rsqf(rowss[r] * (1.0f / 1024.0f) + 1e-6f);
#pragma unroll
                for (int bj = 0; bj < 2; ++bj) {
                    const int col = cb + bj * HALF;
                    f32x4 v0 = (acc[ai][bj][m][0] * rstd + *(const f32x4*)(bias + col)) * qs, v1 = (acc[ai][bj][m][1] * rstd + *(const f32x4*)(bias + col + 4)) * qs;
                    *(u32x4*)(O + (size_t)r * 1280 + col) = pk8(v0, v1);
                    if (pn == 4) {
                        float* dst = nullptr; const int cc = wc * 32 + 8 * fq;
                        if (r < MP_ROWS) { const int t = r & 2047; if (t >= 1920) dst = (bj ? cvp : ckp) + (size_t)((r >> 11) * 128 + t - 1920) * 128 + cc; }
                        else { const int s = r - MP_ROWS; dst = (bj ? cvs : cks) + (size_t)((s >> 3) * 128 + 120 + (s & 7)) * 128 + cc; }
                        if (dst) { *(f32x4*)dst = v0; *(f32x4*)(dst + 4) = v1; }
                    }
                }
                asm volatile("" ::: "memory");
            }
    }
};
}
#ifndef PG8_SP2
#define PG8_SP2 true
#endif
#ifndef PG8_ALIGN
#define PG8_ALIGN true
#endif
#define GAS __attribute__((address_space(1)))
#define LAS __attribute__((address_space(3)))
typedef unsigned short bf16;
typedef unsigned v4u __attribute__((ext_vector_type(4)));
typedef float f32x4 __attribute__((ext_vector_type(4)));
typedef short bf16x8 __attribute__((ext_vector_type(8)));
typedef GAS unsigned gu32;
typedef GAS unsigned long long gu64;
#define RLX_AGENT __ATOMIC_RELAXED, __HIP_MEMORY_SCOPE_AGENT
#define LDS_WAIT() asm volatile("s_waitcnt lgkmcnt(0)" ::: "memory")
#define VM_WAIT() asm volatile("s_waitcnt vmcnt(0)" ::: "memory")
__device__ __forceinline__ unsigned long long rt() { return __builtin_amdgcn_s_memrealtime(); }
__device__ __forceinline__ unsigned f2bf(float f) { unsigned u = __builtin_bit_cast(unsigned, f); return (u + 0x7fffu + ((u >> 16) & 1u)) >> 16; }
__device__ __forceinline__ unsigned pk2(float lo, float hi) { return f2bf(lo) | (f2bf(hi) << 16); }

#define XB_TMO      128
#define XB_XCNT(j)  (256  + 64 * (j))
#define XB_XSUB(j)  (1280 + 64 * (j))
#define XB_XGEN(j)  (2304 + 64 * (j))
#define XB_TOP      3328
#define XB_TOPGEN   3392
#define XCD_BAR_WORDS 3456
#define XB_SPIN_CAP (1u << 18)

__device__ __forceinline__ unsigned xb_ld(unsigned* p)              { return __hip_atomic_load(p, __ATOMIC_RELAXED, __HIP_MEMORY_SCOPE_AGENT); }
__device__ __forceinline__ unsigned xb_add(unsigned* p, unsigned v) { return __hip_atomic_fetch_add(p, v, __ATOMIC_RELAXED, __HIP_MEMORY_SCOPE_AGENT); }
__device__ __forceinline__ unsigned xb_xcc_id() { return (unsigned)__builtin_amdgcn_s_getreg((3 << 11) | 20) & 0xFu; }
#define XB_SPIN(cond, bar) do { unsigned _sp = 0; while (cond) { __builtin_amdgcn_s_sleep(1); \
    if ((++_sp & 255u) == 0u) { if (xb_ld(&(bar)[XB_TMO])) break; if (_sp > XB_SPIN_CAP) { atomicAdd(&(bar)[XB_TMO], 1u); break; } } } } while (0)

struct XcdBarrier {
    unsigned* bar; unsigned x;
    volatile LAS unsigned* st;
};

__device__ __forceinline__ XcdBarrier xcd_barrier_post(unsigned* bar, volatile LAS unsigned* st) {
    XcdBarrier b; b.bar = bar; b.x = xb_xcc_id(); b.st = st;
    if (threadIdx.x == 0) (void)xb_add(&bar[XB_XCNT(b.x)], 1u);
    return b;
}
__device__ __forceinline__ void xcd_barrier_complete(unsigned* bar, unsigned x, unsigned& nloc, unsigned& nx) {
    const unsigned G = gridDim.x * gridDim.y * gridDim.z;
    unsigned sum, cnt, mine, sp = 0u;
    for (;;) {
        sum = 0u; cnt = 0u; mine = 0u;
#pragma unroll
        for (unsigned j = 0; j < 16; ++j) { const unsigned c = xb_ld(&bar[XB_XCNT(j)]); sum += c; cnt += (c > 0u) ? 1u : 0u; mine = (j == x) ? c : mine; }
        if (sum == G) break;
        __builtin_amdgcn_s_sleep(1);
        if ((++sp & 255u) == 0u) { if (xb_ld(&bar[XB_TMO])) break; if (sp > XB_SPIN_CAP) { atomicAdd(&bar[XB_TMO], 1u); break; } }
    }
    nloc = mine > 0u ? mine : 1u; nx = cnt > 0u ? cnt : 1u;
}

__device__ __forceinline__ void xcd_barrier(const XcdBarrier& b) {
    asm volatile("s_waitcnt vmcnt(0)" ::: "memory");
    __syncthreads();
    if (threadIdx.x == 0) {
        unsigned* bar = b.bar;
        __builtin_amdgcn_s_waitcnt(0);
        unsigned nloc = b.st[0], nx = b.st[1];
        if (nloc == 0u) { xcd_barrier_complete(bar, b.x, nloc, nx); b.st[0] = nloc; b.st[1] = nx; }
        const unsigned old = xb_add(&bar[XB_XSUB(b.x)], 1u);
        const unsigned gen = old / nloc;
        if (old + 1u == (gen + 1u) * nloc) {
            __builtin_amdgcn_fence(__ATOMIC_RELEASE, "agent");
            asm volatile("s_waitcnt vmcnt(0)" ::: "memory");
            const unsigned og = xb_add(&bar[XB_TOP], 1u);
            const unsigned tg = og / nx;
            if (og + 1u == (tg + 1u) * nx) xb_add(&bar[XB_TOPGEN], 1u);
            else XB_SPIN(xb_ld(&bar[XB_TOPGEN]) == tg, bar);
            __builtin_amdgcn_fence(__ATOMIC_ACQUIRE, "agent");
            xb_add(&bar[XB_XGEN(b.x)], 1u);
            asm volatile("s_waitcnt vmcnt(0)" ::: "memory");
        } else {
            XB_SPIN(xb_ld(&bar[XB_XGEN(b.x)]) == gen, bar);
            __builtin_amdgcn_fence(__ATOMIC_ACQUIRE, "agent");
            asm volatile("s_waitcnt vmcnt(0)" ::: "memory");
        }
    }
    __syncthreads();
}
#ifndef KNOB_NO0
#define KNOB_NO0 0
#endif
#ifndef KNOB_NO1
#define KNOB_NO1 0
#endif
#ifndef KNOB_NO2
#define KNOB_NO2 0
#endif
#ifndef KNOB_NO3
#define KNOB_NO3 0
#endif
#ifndef KNOB_NO4
#define KNOB_NO4 0
#endif
#ifndef KNOB_NO5
#define KNOB_NO5 0
#endif
#ifndef KNOB_NO6
#define KNOB_NO6 0
#endif
#ifndef KNOB_NO7
#define KNOB_NO7 0
#endif

constexpr int NWAVES = 8;
constexpr int D = 1024, SEQ = 2048, NBATCH = 16, MP = NBATCH * SEQ, NDB = 128, DSEQ = 8, MS = NDB * DSEQ, M = MP + MS, FF = 4096, NZ = 3072, NQKV = 1280;
constexpr int ROPE_ROWS = SEQ + DSEQ;
constexpr float LOG2E = 1.4426950408889634f;
#ifndef MK_N_LAUNCHES
#define MK_N_LAUNCHES 1
#endif
constexpr int N_PHASES = 12, N_LAUNCHES = MK_N_LAUNCHES;
static_assert(N_LAUNCHES == 1 || N_LAUNCHES == N_PHASES, "MK_N_LAUNCHES is 1 or 12");

constexpr size_t MiB = 1u << 20;
constexpr size_t WS_CTL = 0, CTL_ZERO_BYTES = 1 * MiB;
constexpr size_t WS_ROWSS = 256 * 1024;
static_assert(WS_ROWSS + 5 * (size_t)M * 4 <= CTL_ZERO_BYTES, "rowss inside the zeroed region");
constexpr size_t WS_ROPE = 2 * MiB;
constexpr size_t WS_WIN = 5 * MiB, WS_WO0 = 11 * MiB, WS_WUP0 = 13 * MiB, WS_WDN0 = 21 * MiB, WS_WQKV = 29 * MiB, WS_WO1 = 32 * MiB, WS_WUP1 = 34 * MiB, WS_WDN1 = 42 * MiB;
constexpr size_t WS_HB = 50 * MiB;
constexpr size_t WS_BIG = 116 * MiB;
constexpr size_t WS_Z = WS_BIG, WS_OC = 314 * MiB, WS_QKV = WS_BIG, WS_AO = 200 * MiB, WS_END = 380 * MiB;
static_assert(WS_HB + (size_t)M * D * 2 <= WS_BIG && WS_Z + (size_t)M * NZ * 2 <= WS_OC && WS_OC + (size_t)M * D * 2 <= WS_END && WS_BIG + (size_t)M * FF * 2 <= WS_END && WS_QKV + (size_t)M * NQKV * 2 <= WS_AO && WS_AO + (size_t)M * D * 2 <= WS_END, "d_ws map");
constexpr int CW_BAR = 4096;
constexpr size_t OUT_Y = 0, OUT_RETP = (size_t)M * D, OUT_RETS = OUT_RETP + (size_t)NBATCH * 4 * 128 * 128, OUT_GMS = OUT_RETS + (size_t)NDB * 4 * 128 * 128, OUT_CKP = OUT_GMS + (size_t)NDB * DSEQ * 512,
                 OUT_CVP = OUT_CKP + (size_t)NBATCH * 128 * 128, OUT_CKS = OUT_CVP + (size_t)NBATCH * 128 * 128, OUT_CVS = OUT_CKS + (size_t)NDB * 128 * 128, OUT_END = OUT_CVS + (size_t)NDB * 128 * 128;
constexpr int RING_OFF = 0, SCR_BYTES = 143360, LDSCTL_OFF = SCR_BYTES, MISC_OFF = LDSCTL_OFF + 320, LDS_BYTES = 147456;

__device__ __forceinline__ float bf2f(unsigned short b) { return __uint_as_float(((unsigned)b) << 16); }
__device__ __forceinline__ float wave_sum(float v) {
#pragma unroll
    for (int o = 1; o < 64; o <<= 1) v += __shfl_xor(v, o);
    return v;
}
__device__ __forceinline__ int win_destrow(int n) {
    if (n >= 1024) return n;
    const int d = n & 127, nb = d >> 6, dl = d & 63, wc = dl >> 4, fq = (dl >> 2) & 3, e = dl & 3;
    return (n & ~127) + 32 * wc + 8 * fq + 4 * nb + e;
}
template <int MODE> __device__ __forceinline__ void p0_transpose_item(const float* W, int K, int N, bf16* WT, const float* gain, LAS float* scr, int item, int lane) {
    const int nblk = N / 32, kb = item / nblk, nb = item % nblk, k0 = 64 * kb, n0 = 32 * nb;
#pragma unroll 8
    for (int i = 0; i < 32; ++i) { const int kk = 2 * i + (lane >> 5); float w = W[(size_t)(k0 + kk) * N + n0 + (lane & 31)]; if (gain) w *= gain[k0 + kk]; scr[kk * 33 + (lane & 31)] = w; }
    LDS_WAIT(); asm volatile("" ::: "memory");
    const int c = lane & 7;
#pragma unroll
    for (int j = 0; j < 4; ++j) { const int n = (lane >> 3) + 8 * j; const LAS float* s = scr + (8 * c) * 33 + n;
        v4u o; o.x = pk2(s[0 * 33], s[1 * 33]); o.y = pk2(s[2 * 33], s[3 * 33]); o.z = pk2(s[4 * 33], s[5 * 33]); o.w = pk2(s[6 * 33], s[7 * 33]);
        const int dr = MODE ? win_destrow(n0 + n) : (n0 + n);
        *(GAS v4u*)(WT + (size_t)dr * K + k0 + 8 * c) = o; }
    LDS_WAIT(); asm volatile("" ::: "memory");
}
__device__ __forceinline__ void rope_entry(int pos, int j, float& c, float& s) {
    double inv = 1.0, p = 0.8659643233600653;
#pragma unroll
    for (int b = 0; b < 6; ++b) { if ((j >> b) & 1) inv *= p; p *= p; }
    const double rev = (double)pos * inv * 0.15915494309189535;
    const double fr = rev - __builtin_rint(rev);
    const double q = __builtin_rint(fr * 4.0); const double r = (fr - q * 0.25) * 6.283185307179586; const double r2 = r * r;
    double sn = -1.0 / 6227020800.0; sn = sn * r2 + 1.0 / 39916800.0; sn = sn * r2 - 1.0 / 362880.0; sn = sn * r2 + 1.0 / 5040.0; sn = sn * r2 - 1.0 / 120.0; sn = sn * r2 + 1.0 / 6.0; sn = r - r * r2 * sn;
    double cn = 1.0 / 87178291200.0; cn = cn * r2 - 1.0 / 479001600.0; cn = cn * r2 + 1.0 / 3628800.0; cn = cn * r2 - 1.0 / 40320.0; cn = cn * r2 + 1.0 / 720.0; cn = cn * r2 - 1.0 / 24.0; cn = cn * r2 + 0.5; cn = 1.0 - r2 * cn;
    const int qi = ((int)q) & 3;
    const double cc = qi == 0 ? cn : qi == 1 ? -sn : qi == 2 ? -cn : sn, ss = qi == 0 ? sn : qi == 1 ? cn : qi == 2 ? -sn : -cn;
    c = (float)cc; s = (float)ss;
}

__device__ __forceinline__ void ret_unit_naive(const bf16* Z, bf16* OC, int rowbase, int ntok, int cmask, int h, const float* S_in, float* S_out, float gC, float* sm, int tid) {
    const int dv = tid & 127, dq = tid >> 7, lane = tid & 63, wave = tid >> 6;
    float S[32];
#pragma unroll
    for (int kk = 0; kk < 32; ++kk) S[kk] = S_in ? S_in[(dq * 32 + kk) * 128 + dv] : 0.f;
    float* sq = sm; float* sk = sm + 1024; float* sv = sm + 2048; float* red = sm + 3072;
    for (int t0 = 0; t0 < ntok; t0 += 8) {
#pragma unroll
        for (int i = 0; i < 6; ++i) { const int e = tid + 512 * i, arr = e >> 10, rem = e & 1023, tt = rem >> 7, d = rem & 127;
            sm[e] = bf2f(Z[(size_t)(rowbase + t0 + tt) * NZ + arr * 512 + h * 128 + d]); }
        __syncthreads();
#pragma unroll 1
        for (int tt = 0; tt < 8; ++tt) {
            const float vv = sv[tt * 128 + dv]; float a = 0.f;
#pragma unroll
            for (int kk = 0; kk < 32; ++kk) { S[kk] = fmaf(sk[tt * 128 + dq * 32 + kk], vv, S[kk]); a = fmaf(sq[tt * 128 + dq * 32 + kk], S[kk], a); }
            red[(tt * 4 + dq) * 128 + dv] = a;
            if (((t0 + tt) & cmask) == cmask) {
#pragma unroll
                for (int kk = 0; kk < 32; ++kk) S[kk] *= gC; }
        }
        __syncthreads();
        { const int tt = wave; const size_t row = (size_t)(rowbase + t0 + tt);
          float o0 = 0.f, o1 = 0.f;
#pragma unroll
          for (int q4 = 0; q4 < 4; ++q4) { o0 += red[(tt * 4 + q4) * 128 + lane]; o1 += red[(tt * 4 + q4) * 128 + lane + 64]; }
          const float ss = wave_sum(o0 * o0 + o1 * o1); const float rs = 1.0f / sqrtf(ss * (1.0f / 128.0f) + 1e-6f);
          const float g0 = bf2f(Z[row * NZ + 1536 + h * 128 + lane]), g1 = bf2f(Z[row * NZ + 1536 + h * 128 + lane + 64]);
          OC[row * D + h * 128 + lane] = (bf16)f2bf(o0 * rs * g0); OC[row * D + h * 128 + lane + 64] = (bf16)f2bf(o1 * rs * g1); }
        __syncthreads();
    }
#pragma unroll
    for (int kk = 0; kk < 32; ++kk) S_out[(dq * 32 + kk) * 128 + dv] = S[kk];
}
__device__ __forceinline__ void gm_unit_naive(const bf16* Z, bf16* OC, int rowbase, int ntok, int g, const float* w_s, const float* b_s, const float* ln_g, const float* ln_b, float* gvn_out, float* sm, int tid) {
    const int lane = tid & 63, wave = tid >> 6;
    for (int i = wave; i < ntok; i += 8) { const size_t row = (size_t)(rowbase + i);
        const float x0 = bf2f(Z[row * NZ + 2560 + g * 128 + lane]), x1 = bf2f(Z[row * NZ + 2560 + g * 128 + lane + 64]);
        const float mu = wave_sum(x0 + x1) * (1.0f / 128.0f); const float d0 = x0 - mu, d1 = x1 - mu;
        const float var = wave_sum(d0 * d0 + d1 * d1) * (1.0f / 128.0f); const float rs = 1.0f / sqrtf(var + 1e-5f);
        const float y0 = d0 * rs * ln_g[g * 128 + lane] + ln_b[g * 128 + lane], y1 = d1 * rs * ln_g[g * 128 + lane + 64] + ln_b[g * 128 + lane + 64];
        sm[i * 128 + lane] = y0; sm[i * 128 + lane + 64] = y1;
        if (gvn_out) { gvn_out[i * 512 + g * 128 + lane] = y0; gvn_out[i * 512 + g * 128 + lane + 64] = y1; } }
    __syncthreads();
    const int d = tid & 127, iq = tid >> 7;
    for (int i = iq; i < ntok; i += 4) { float a = b_s[g * 128 + i]; const float* wr = w_s + (size_t)(g * 128 + i) * 128;
        for (int j = 0; j <= i; ++j) a = fmaf(wr[j], sm[j * 128 + d], a);
        const size_t row = (size_t)(rowbase + i); const float uu = bf2f(Z[row * NZ + 2048 + g * 128 + d]);
        OC[row * D + 512 + g * 128 + d] = (bf16)f2bf(uu * a); }
    __syncthreads();
}
__device__ __forceinline__ void attn_pair_naive(const bf16* qp, bf16* op, const float* sK, const float* sV, int j0, int jvalid, float sink) {
    float q[64], o[64];
#pragma unroll
    for (int c = 0; c < 8; ++c) { const v4u w = *(const v4u*)(qp + 8 * c);
        q[8 * c + 0] = __uint_as_float(w.x << 16); q[8 * c + 1] = __uint_as_float(w.x & 0xffff0000u); q[8 * c + 2] = __uint_as_float(w.y << 16); q[8 * c + 3] = __uint_as_float(w.y & 0xffff0000u);
        q[8 * c + 4] = __uint_as_float(w.z << 16); q[8 * c + 5] = __uint_as_float(w.z & 0xffff0000u); q[8 * c + 6] = __uint_as_float(w.w << 16); q[8 * c + 7] = __uint_as_float(w.w & 0xffff0000u); }
#pragma unroll
    for (int d = 0; d < 64; ++d) o[d] = 0.f;
    float m2 = sink * LOG2E, l = 1.0f;
    for (int jj = 0; jj <= 128; ++jj) { const int j = j0 + jj;
        if (j >= jvalid) {
            const float* kr = sK + j * 68; float s = 0.f;
#pragma unroll
            for (int c = 0; c < 16; ++c) { const f32x4 kv = *(const f32x4*)(kr + 4 * c); s = fmaf(q[4 * c], kv[0], s); s = fmaf(q[4 * c + 1], kv[1], s); s = fmaf(q[4 * c + 2], kv[2], s); s = fmaf(q[4 * c + 3], kv[3], s); }
            s *= LOG2E;
            if (s > m2) { const float sc = __builtin_amdgcn_exp2f(m2 - s); l *= sc;
#pragma unroll
                for (int d = 0; d < 64; ++d) o[d] *= sc;
                m2 = s; }
            const float p = __builtin_amdgcn_exp2f(s - m2); l += p; const float* vr = sV + j * 68;
#pragma unroll
            for (int c = 0; c < 16; ++c) { const f32x4 vv = *(const f32x4*)(vr + 4 * c); o[4 * c] = fmaf(p, vv[0], o[4 * c]); o[4 * c + 1] = fmaf(p, vv[1], o[4 * c + 1]); o[4 * c + 2] = fmaf(p, vv[2], o[4 * c + 2]); o[4 * c + 3] = fmaf(p, vv[3], o[4 * c + 3]); }
        } }
    const float inv = 1.0f / l;
#pragma unroll
    for (int c = 0; c < 8; ++c) { v4u w; w.x = pk2(o[8 * c] * inv, o[8 * c + 1] * inv); w.y = pk2(o[8 * c + 2] * inv, o[8 * c + 3] * inv); w.z = pk2(o[8 * c + 4] * inv, o[8 * c + 5] * inv); w.w = pk2(o[8 * c + 6] * inv, o[8 * c + 7] * inv);
        *(v4u*)(op + 8 * c) = w; }
}

struct Args { const float* in[21]; float* out; unsigned char* ws; int ph_lo, ph_hi, li, pad; };
__global__ void __launch_bounds__(NWAVES * 64, 2) fwd_kernel(Args args) {
    extern __shared__ __attribute__((aligned(16))) unsigned char lds[];
    LAS unsigned char* const L = (LAS unsigned char*)lds;
    volatile LAS unsigned* const MISC = (volatile LAS unsigned*)(L + MISC_OFF);
    const int tid = threadIdx.x, lane = tid & 63, wave = __builtin_amdgcn_readfirstlane(tid >> 6);
    const int G = gridDim.x, bx = blockIdx.x, vcu = (G % 8 == 0) ? (bx % 8) * (G / 8) + bx / 8 : bx;
    unsigned char* const ws = args.ws; float* const out = args.out;
    gu32* const ctl = (gu32*)(ws + WS_CTL);
    for (int u = tid; u < (LDS_BYTES - LDSCTL_OFF) / 4; u += NWAVES * 64) ((LAS unsigned*)(L + LDSCTL_OFF))[u] = 0u;
    __syncthreads();
    XcdBarrier bar; bar.bar = (unsigned*)(ctl + CW_BAR); bar.x = 0; bar.st = nullptr;
    if (N_LAUNCHES == 1) bar = xcd_barrier_post((unsigned*)(ctl + CW_BAR), MISC + 8);
#define GRID_BAR() do { if (N_LAUNCHES == 1) xcd_barrier(bar); } while (0)
    const int lo = args.ph_lo, hi = args.ph_hi;
#define IN(k) (lo <= (k) && (k) < hi)
#define BOTH(k) (IN(k) && IN((k) + 1))
    float* const sm = (float*)lds;
#define INP(i) (args.in[i])
#define WSP(T, off) ((T*)(ws + (off)))
#define ROWSS(k) (WSP(float, WS_ROWSS) + (size_t)(k) * M)
#define ROPEC WSP(float, WS_ROPE)
#define ROPES (WSP(float, WS_ROPE) + ROPE_ROWS * 64)

    if (IN(0) && !KNOB_NO0) {
        LAS float* scr = (LAS float*)(L + RING_OFF + wave * 16384);
        const int gw = vcu * NWAVES + wave, NGW = G * NWAVES;
        constexpr int I0 = 16 * 96, I1 = 16 * 32, I2 = 16 * 128, I3 = 64 * 32, I4 = 16 * 40, I5 = 16 * 32, I6 = 16 * 128, I7 = 64 * 32, NITEMS = I0 + I1 + I2 + I3 + I4 + I5 + I6 + I7;
        for (int it = gw; it < NITEMS; it += NGW) {
            int r = it;
            if (r < I0) { p0_transpose_item<1>(INP(8), D, NZ, WSP(bf16, WS_WIN), INP(5), scr, r, lane); continue; } r -= I0;
            if (r < I1) { p0_transpose_item<0>(INP(13), D, D, WSP(bf16, WS_WO0), nullptr, scr, r, lane); continue; } r -= I1;
            if (r < I2) { p0_transpose_item<0>(INP(19), D, FF, WSP(bf16, WS_WUP0), INP(6), scr, r, lane); continue; } r -= I2;
            if (r < I3) { p0_transpose_item<0>(INP(20), FF, D, WSP(bf16, WS_WDN0), nullptr, scr, r, lane); continue; } r -= I3;
            if (r < I4) { p0_transpose_item<0>(INP(14), D, NQKV, WSP(bf16, WS_WQKV), INP(5) + D, scr, r, lane); continue; } r -= I4;
            if (r < I5) { p0_transpose_item<0>(INP(17), D, D, WSP(bf16, WS_WO1), nullptr, scr, r, lane); continue; } r -= I5;
            if (r < I6) { p0_transpose_item<0>(INP(19) + (size_t)D * FF, D, FF, WSP(bf16, WS_WUP1), INP(6) + D, scr, r, lane); continue; } r -= I6;
            p0_transpose_item<0>(INP(20) + (size_t)FF * D, FF, D, WSP(bf16, WS_WDN1), nullptr, scr, r, lane);
        }
        for (int m = gw; m < M; m += NGW) {
            const float* xrow = m < MP ? INP(0) + (size_t)m * D : INP(1) + (size_t)(m - MP) * D;
            const GAS f32x4* xr = (const GAS f32x4*)xrow + lane; f32x4 v[4]; float s = 0.f;
#pragma unroll
            for (int j = 0; j < 4; ++j) { v[j] = xr[64 * j]; s += (v[j].x * v[j].x + v[j].y * v[j].y) + (v[j].z * v[j].z + v[j].w * v[j].w); }
            s = wave_sum(s); if (lane == 0) ROWSS(0)[m] = s;
            GAS unsigned long long* o8 = (GAS unsigned long long*)(WSP(bf16, WS_HB) + (size_t)m * D) + lane;
#pragma unroll
            for (int j = 0; j < 4; ++j) o8[64 * j] = (unsigned long long)pk2(v[j].x, v[j].y) | ((unsigned long long)pk2(v[j].z, v[j].w) << 32);
        }
        const int gt = vcu * (NWAVES * 64) + tid, NT = G * NWAVES * 64;
        for (int idx = gt; idx < ROPE_ROWS * 64; idx += NT) { const int trow = idx >> 6, j = idx & 63, pos = trow < SEQ ? trow : 16384 + (trow - SEQ); float c, s; rope_entry(pos, j, c, s); ROPEC[idx] = c; ROPES[idx] = s; }
        for (int idx = gt; idx < 2 * NDB * 3840; idx += NT) { const int which = idx / (NDB * 3840), rem = idx % (NDB * 3840), db = rem / 3840, o4 = rem % 3840;
            const f32x4 v = *((const f32x4*)((which ? INP(4) : INP(3)) + (size_t)db * 16384 + 1024) + o4);
            *((f32x4*)(out + (which ? OUT_CVS : OUT_CKS) + (size_t)db * 16384) + o4) = v; }
        if (BOTH(0)) GRID_BAR();
    }
    if (IN(1) && !KNOB_NO1) {
        pg8::Gemm g{WSP(bf16, WS_HB), WSP(bf16, WS_WIN), M, NZ, D}; pg8::StaticOrder S; S.init(M, NZ, G, bx);
        pg8::EpiAB E{WSP(bf16, WS_Z), ROWSS(0), ROPEC, ROPES};
        pg8::gemm_phase<pg8::EpiAB, pg8::StaticOrder, PG8_ALIGN, PG8_SP2>(L + RING_OFF, g, S, E);
        if (BOTH(1)) GRID_BAR();
    }
    if (IN(2) && !KNOB_NO2) {
        bf16* const Z = WSP(bf16, WS_Z); bf16* const OC = WSP(bf16, WS_OC);
        if (vcu < 64) { const int b = vcu >> 2, h = vcu & 3;
            ret_unit_naive(Z, OC, b * SEQ, SEQ, 127, h, nullptr, out + OUT_RETP + (size_t)(b * 4 + h) * 16384, exp2f(128.0f * log2f(1.0f - exp2f(-5.0f - (float)h))), sm, tid);
        } else {
            const int nother = G - 64;
            for (int uid = vcu - 64; uid < 1024 + 512; uid += nother) {
                if (uid < 1024) { const int b = uid >> 6, n = (uid >> 2) & 15, g = uid & 3;
                    gm_unit_naive(Z, OC, b * SEQ + n * 128, 128, g, INP(9), INP(10), INP(11), INP(12), nullptr, sm, tid);
                } else { const int su = uid - 1024, db = su >> 2, h = su & 3;
                    ret_unit_naive(Z, OC, MP + db * 8, 8, 7, h, INP(2) + (size_t)(db * 4 + h) * 16384, out + OUT_RETS + (size_t)(db * 4 + h) * 16384, exp2f(8.0f * log2f(1.0f - exp2f(-5.0f - (float)h))), sm, tid);
                    gm_unit_naive(Z, OC, MP + db * 8, 8, h, INP(9), INP(10), INP(11), INP(12), out + OUT_GMS + (size_t)db * 8 * 512, sm, tid);
                }
            }
        }
        if (BOTH(2)) GRID_BAR();
    }
    if (IN(3) && !KNOB_NO3) {
        pg8::Gemm g{WSP(bf16, WS_OC), WSP(bf16, WS_WO0), M, D, D}; pg8::StaticOrder S; S.init(M, D, G, bx);
        pg8::EpiRes E{INP(0), INP(1), out, WSP(bf16, WS_HB), ROWSS(1), nullptr};
        pg8::gemm_phase<pg8::EpiRes, pg8::StaticOrder, PG8_ALIGN, PG8_SP2>(L + RING_OFF, g, S, E);
        if (BOTH(3)) GRID_BAR();
    }
    if (IN(4) && !KNOB_NO4) {
        pg8::Gemm g{WSP(bf16, WS_HB), WSP(bf16, WS_WUP0), M, FF, D}; pg8::StaticOrder S; S.init(M, FF, G, bx);
        pg8::EpiUp E{WSP(bf16, WS_BIG), ROWSS(1)};
        pg8::gemm_phase<pg8::EpiUp, pg8::StaticOrder, PG8_ALIGN, PG8_SP2>(L + RING_OFF, g, S, E);
        if (BOTH(4)) GRID_BAR();
    }
    if (IN(5) && !KNOB_NO5) {
        pg8::Gemm g{WSP(bf16, WS_BIG), WSP(bf16, WS_WDN0), M, D, FF}; pg8::StaticOrder S; S.init(M, D, G, bx);
        pg8::EpiRes E{out, out + (size_t)MP * D, out, WSP(bf16, WS_HB), ROWSS(2), nullptr};
        pg8::gemm_phase<pg8::EpiRes, pg8::StaticOrder, PG8_ALIGN, PG8_SP2>(L + RING_OFF, g, S, E);
        if (BOTH(5)) GRID_BAR();
    }
    if (IN(6) && !KNOB_NO6) {
        pg8::Gemm g{WSP(bf16, WS_HB), WSP(bf16, WS_WQKV), M, NQKV, D}; pg8::StaticOrder S; S.init(M, NQKV, G, bx);
        pg8::EpiQKV E{WSP(bf16, WS_QKV), ROWSS(2), INP(15), out + OUT_CKP, out + OUT_CVP, out + OUT_CKS, out + OUT_CVS};
        pg8::gemm_phase<pg8::EpiQKV, pg8::StaticOrder, PG8_ALIGN, PG8_SP2>(L + RING_OFF, g, S, E);
        if (BOTH(6)) GRID_BAR();
    }
    if (IN(7) && !KNOB_NO7) {
        bf16* const QKV = WSP(bf16, WS_QKV); bf16* const AO = WSP(bf16, WS_AO); const float* const swa_sinks = INP(16); const float* const cache_k = INP(3); const float* const cache_v = INP(4);
        float* sK = sm; float* sV = sm + 256 * 68;
        for (int uid = vcu; uid < 512 + 256; uid += G) {
            if (uid < 512) { const int b = uid >> 5, n = (uid >> 1) & 15, kvh = uid & 1;
                for (int e = tid; e < 256 * 64; e += 512) { const int j = e >> 6, d = e & 63, tok = n * 128 - 128 + j; float kk = 0.f, vv = 0.f;
                    if (tok >= 0) { const size_t row = (size_t)(b * SEQ + tok); kk = bf2f(QKV[row * NQKV + 1024 + kvh * 64 + d]); vv = bf2f(QKV[row * NQKV + 1152 + kvh * 64 + d]); }
                    sK[j * 68 + d] = kk; sV[j * 68 + d] = vv; }
                __syncthreads();
#pragma unroll 1
                for (int pp = 0; pp < 2; ++pp) { const int p = tid + 512 * pp, i = p & 127, head = kvh * 8 + (p >> 7); const size_t row = (size_t)(b * SEQ + n * 128 + i);
                    attn_pair_naive(QKV + row * NQKV + head * 64, AO + row * D + head * 64, sK, sV, i, n > 0 ? 0 : 128, swa_sinks[head]); }
                __syncthreads();
            } else { const int su = uid - 512, db = su >> 1, kvh = su & 1;
                for (int e = tid; e < 136 * 64; e += 512) { const int j = e >> 6, d = e & 63; float kk, vv;
                    if (j < 128) { kk = cache_k[(size_t)(db * 128 + j) * 128 + kvh * 64 + d]; vv = cache_v[(size_t)(db * 128 + j) * 128 + kvh * 64 + d]; }
                    else { const size_t row = (size_t)(MP + db * 8 + j - 128); kk = bf2f(QKV[row * NQKV + 1024 + kvh * 64 + d]); vv = bf2f(QKV[row * NQKV + 1152 + kvh * 64 + d]); }
                    sK[j * 68 + d] = kk; sV[j * 68 + d] = vv; }
                __syncthreads();
                if (tid < 64) { const int i = tid & 7, head = kvh * 8 + (tid >> 3); const size_t row = (size_t)(MP + db * 8 + i);
                    attn_pair_naive(QKV + row * NQKV + head * 64, AO + row * D + head * 64, sK, sV, i, 0, swa_sinks[head]); }
                __syncthreads();
            }
        }
        if (BOTH(7)) GRID_BAR();
    }
    if (IN(8) && !KNOB_NO3) {
        pg8::Gemm g{WSP(bf16, WS_AO), WSP(bf16, WS_WO1), M, D, D}; pg8::StaticOrder S; S.init(M, D, G, bx);
        pg8::EpiRes E{out, out + (size_t)MP * D, out, WSP(bf16, WS_HB), ROWSS(3), INP(18)};
        pg8::gemm_phase<pg8::EpiRes, pg8::StaticOrder, PG8_ALIGN, PG8_SP2>(L + RING_OFF, g, S, E);
        if (BOTH(8)) GRID_BAR();
    }
    if (IN(9) && !KNOB_NO4) {
        pg8::Gemm g{WSP(bf16, WS_HB), WSP(bf16, WS_WUP1), M, FF, D}; pg8::StaticOrder S; S.init(M, FF, G, bx);
        pg8::EpiUp E{WSP(bf16, WS_BIG), ROWSS(3)};
        pg8::gemm_phase<pg8::EpiUp, pg8::StaticOrder, PG8_ALIGN, PG8_SP2>(L + RING_OFF, g, S, E);
        if (BOTH(9)) GRID_BAR();
    }
    if (IN(10) && !KNOB_NO5) {
        pg8::Gemm g{WSP(bf16, WS_BIG), WSP(bf16, WS_WDN1), M, D, FF}; pg8::StaticOrder S; S.init(M, D, G, bx);
        pg8::EpiRes E{out, out + (size_t)MP * D, out, nullptr, ROWSS(4), nullptr};
        pg8::gemm_phase<pg8::EpiRes, pg8::StaticOrder, PG8_ALIGN, PG8_SP2>(L + RING_OFF, g, S, E);
        if (BOTH(10)) GRID_BAR();
    }
    if (IN(11)) {
        const int gw = vcu * NWAVES + wave, NGW = G * NWAVES; const float* rs4 = ROWSS(4); const float* const norm_final = INP(7);
        for (int m = gw; m < M; m += NGW) {
            const float rstd = 1.0f / sqrtf(rs4[m] * (1.0f / 1024.0f) + 1e-6f);
            GAS f32x4* yr = (GAS f32x4*)(out + (size_t)m * D) + lane; const GAS f32x4* gr = (const GAS f32x4*)norm_final + lane;
#pragma unroll
            for (int j = 0; j < 4; ++j) yr[64 * j] = yr[64 * j] * rstd * gr[64 * j];
        }
    }
#undef IN
#undef BOTH
#undef GRID_BAR
}

extern "C" void kernel_launch(void* const* d_in, const int* in_sizes, int n_in, void* d_out, int out_size, void* d_ws, size_t ws_size, hipStream_t stream) {
    static int grid = 0;
    if (grid == 0) {
        if (n_in != 21 || in_sizes[0] != MP * D || (size_t)out_size != OUT_END || ws_size < WS_END) { fprintf(stderr, "kernel_launch: unexpected shapes (n_in %d, in0 %d, out %d, ws %zu); nothing launched\n", n_in, n_in > 0 ? in_sizes[0] : -1, out_size, ws_size); grid = -1; return; }
        int dev = 0, cus = 0, per_cu = 0;
        if (hipGetDevice(&dev) != hipSuccess || hipDeviceGetAttribute(&cus, hipDeviceAttributeMultiprocessorCount, dev) != hipSuccess) { fprintf(stderr, "kernel_launch: device query failed\n"); grid = -1; return; }
        if (hipFuncSetAttribute((const void*)fwd_kernel, hipFuncAttributeMaxDynamicSharedMemorySize, LDS_BYTES) != hipSuccess) { fprintf(stderr, "kernel_launch: hipFuncSetAttribute failed\n"); grid = -1; return; }
        if (hipOccupancyMaxActiveBlocksPerMultiprocessor(&per_cu, (const void*)fwd_kernel, NWAVES * 64, LDS_BYTES) != hipSuccess || per_cu < 1) fprintf(stderr, "kernel_launch: note: occupancy query reports %d workgroups per CU\n", per_cu);
        (void)hipGetLastError();
        grid = cus;
    }
    if (grid < 0) return;
    if (hipMemsetAsync((char*)d_ws + WS_CTL, 0, CTL_ZERO_BYTES, stream) != hipSuccess) { fprintf(stderr, "kernel_launch: hipMemsetAsync failed\n"); return; }
    Args a{};
    for (int i = 0; i < 21; ++i) a.in[i] = (const float*)d_in[i];
    a.out = (float*)d_out; a.ws = (unsigned char*)d_ws;
    for (int li = 0; li < N_LAUNCHES; ++li) {
        a.ph_lo = (N_LAUNCHES == 1) ? 0 : li; a.ph_hi = (N_LAUNCHES == 1) ? N_PHASES : li + 1; a.li = li;
        hipLaunchKernelGGL(fwd_kernel, dim3(grid), dim3(NWAVES * 64), LDS_BYTES, stream, a);
        const hipError_t le = hipPeekAtLastError();
        if (le != hipSuccess) { fprintf(stderr, "kernel_launch: launch %d failed: %s\n", li, hipGetErrorName(le)); break; }
    }
}
```

```cpp
#define FINE128 0
#include <hip/hip_runtime.h>
#include <cstdio>
#include <cstdint>
namespace pg8 {
#define PG8_LAS __attribute__((address_space(3)))
typedef unsigned short bf16_t;
typedef short bf16x8 __attribute__((ext_vector_type(8)));
typedef float f32x4 __attribute__((ext_vector_type(4)));
typedef unsigned u32x4 __attribute__((ext_vector_type(4)));
constexpr int BM = 256, BK = 64, HALF = 128, HTB = HALF * BK * 2  , STAGE_BYTES = 8 * HTB, NXCD = 8, WGM = 8;

__host__ __device__ __forceinline__ int lds_byte(int r, int c) { const int st = (r >> 4) * 2 + (c >> 5), rr = r & 15, cc = c & 31, ob = rr * 64 + cc * 2; return st * 1024 + (ob ^ (((ob >> 9) & 1) << 5)); }
__host__ __device__ __forceinline__ void stage_rc(int b, int& R, int& C) { const int st = b / 1024, sb = b % 1024, swz = sb ^ (((sb >> 9) & 1) << 5); R = (st >> 1) * 16 + swz / 64; C = (st & 1) * 32 + (swz % 64) / 2; }
__host__ __device__ __forceinline__ int perm32(int rho) { const int n = rho >> 4, i = rho & 15; return 8 * (i >> 2) + 4 * n + (i & 3); }

struct Unit { int pm, pn; };
struct Gemm { const bf16_t* A; const bf16_t* Bt; int M, N, K, lda; };

struct StaticOrder {
    int nM, nN, nwg, G, c;
    __host__ __device__ void init(int M, int N, int G_, int c_) { nM = M / BM; nN = N / BM; nwg = nM * nN; G = G_; c = c_; }
    __host__ __device__ bool next(int i, Unit& u) const {
        const long L = (long)i * G + c; if (L >= nwg) return false;
        int wgid = (int)L; { const int q = nwg / NXCD, r = nwg % NXCD, xcd = wgid % NXCD, off = wgid / NXCD; wgid = (xcd < r ? xcd * (q + 1) : r * (q + 1) + (xcd - r) * q) + off; }
        const int nig = WGM * nN, gid = wgid / nig, fm = gid * WGM, gsz = (nM - fm) < WGM ? (nM - fm) : WGM;
        u.pm = fm + ((wgid % nig) % gsz); u.pn = (wgid % nig) / gsz; return true;
    }
    __device__ __forceinline__ void a_ready(const Unit&) const {}
    __device__ __forceinline__ void done(const Unit&) const {}
};

__device__ __forceinline__ unsigned cvt_pk_bf16(float lo, float hi) { unsigned r; asm volatile("v_cvt_pk_bf16_f32 %0, %1, %2" : "=v"(r) : "v"(lo), "v"(hi)); return r; }
typedef float f32x2 __attribute__((ext_vector_type(2)));
__device__ __forceinline__ f32x2 gelu_pk(f32x2 v) {
    const f32x2 av = __builtin_elementwise_abs(v), d = av * 0.2316418882f + 1.0f;
    f32x2 t; t.x = __builtin_amdgcn_rcpf(d.x); t.y = __builtin_amdgcn_rcpf(d.y);
    f32x2 q = t * 0.5307027145f + (-0.7265760135f); q = q * t + 0.7107068705f; q = q * t + (-0.142248368f); q = q * t + 0.127414796f; q = q * t;
    const f32x2 s = (v * v) * (-0.72134752044f);
    f32x2 e; e.x = __builtin_amdgcn_exp2f(s.x); e.y = __builtin_amdgcn_exp2f(s.y);
    const f32x2 m = v * (q * e), r = v - m;
    f32x2 o; o.x = v.x < 0.f ? m.x : r.x; o.y = v.y < 0.f ? m.y : r.y; return o;
}

#ifndef PG8_PEEL
#define PG8_PEEL 1
#endif
template <class Epi, class Sched, bool ALIGN_EPI = false, bool SP2 = false>
__device__ __forceinline__ void gemm_phase(PG8_LAS unsigned char* lds, const Gemm g, const Sched& S, const Epi& E, int& tid_io) {
    int tid_l = tid_io; asm volatile("" : "+v"(tid_l));
    const int tid = tid_l, wid = __builtin_amdgcn_readfirstlane(tid >> 6), lane = tid & 63, wr = wid >> 2, wc = wid & 3, fr = lane & 15, fq = lane >> 4;
    const int K = g.K, nt = K / BK;
    unsigned voffA, voffB;
    { int R, C; stage_rc(tid * 16, R, C); const int Rb = Epi::PERM ? ((R & ~31) + perm32(R & 31)) : R;
      voffA = (unsigned)(R * g.lda + C) * 2u; voffB = (unsigned)(Rb * K + C) * 2u; }
    const unsigned p2offA = 64u * (unsigned)g.lda * 2u, p2offB = 64u * (unsigned)K * 2u;
    const size_t kstep = (size_t)(BK * 2);
    const size_t hstep = (size_t)HALF * K * 2;
    const size_t hstepA = (size_t)HALF * g.lda * 2, tstepA = 2 * hstepA;
    const size_t tstep = 2 * hstep;
    const unsigned ldsw = (unsigned)wid * 1024u;
    const int aoff = lds_byte(wr * 64 + fr, fq * 8), boff = lds_byte(wc * 32 + fr, fq * 8);
#define PG8_SA(b, h) (((b) * 2 + (h)) * HTB)
#define PG8_SB(b, h) ((4 + (b) * 2 + (h)) * HTB)
#define PG8_STAGE(bufoff, gbase, voff) do { _Pragma("unroll") for (int _i = 0; _i < 2; ++_i) \
        { unsigned vo_ = v##voff; if (_i) asm volatile("v_add_u32 %0, %1, %2" : "=v"(vo_) : "v"(v##voff), "s"(p2##voff));     \
          __builtin_amdgcn_global_load_lds((const unsigned*)((const char*)(gbase) + vo_), (PG8_LAS unsigned*)(lds + (bufoff) + ldsw + _i * 8192), 16, 0, 0); } } while (0)
#define PG8_LDA(dst, b, h) do { _Pragma("unroll") for (int m = 0; m < 4; ++m) _Pragma("unroll") for (int k = 0; k < 2; ++k) dst[m][k] = *(const PG8_LAS bf16x8*)(lds + PG8_SA(b, h) + aoff + m * 2048 + k * 1024); } while (0)
#define PG8_LDB(dst, b, h) do { _Pragma("unroll") for (int n = 0; n < 2; ++n) _Pragma("unroll") for (int k = 0; k < 2; ++k) dst[n][k] = *(const PG8_LAS bf16x8*)(lds + PG8_SB(b, h) + boff + n * 2048 + k * 1024); } while (0)
#define PG8_MMA(ai, bj, At, Bt) do { __builtin_amdgcn_s_setprio(1); _Pragma("unroll") for (int m = 0; m < 4; ++m) _Pragma("unroll") for (int n = 0; n < 2; ++n) _Pragma("unroll") for (int k = 0; k < 2; ++k) \
        acc[ai][bj][m][n] = __builtin_amdgcn_mfma_f32_16x16x32_bf16(Bt[n][k], At[m][k], acc[ai][bj][m][n], 0, 0, 0); __builtin_amdgcn_s_setprio(0); } while (0)
#define PG8_WAIT_V(n) asm volatile("s_waitcnt vmcnt(" #n ")" ::: "memory")
#define PG8_WAIT_L(n) asm volatile("s_waitcnt lgkmcnt(" #n ")" ::: "memory")
#define PG8_BAR __builtin_amdgcn_s_barrier()
#define PG8_SCHED __builtin_amdgcn_sched_barrier(0)
    Unit cur, nxt; int ui = 0;
    if (!S.next(0, cur)) return;
    f32x4 acc[2][2][4][2];
    [[maybe_unused]] u32x4 hraw[2][4][2];
    if constexpr (Epi::ACC_INIT) E.load_h(hraw, cur, wr, wc);
    else {
#pragma unroll
    for (int a = 0; a < 2; ++a)
#pragma unroll
        for (int b = 0; b < 2; ++b)
#pragma unroll
            for (int m = 0; m < 4; ++m)
#pragma unroll
                for (int n = 0; n < 2; ++n) acc[a][b][m][n] = (f32x4){0.f, 0.f, 0.f, 0.f};
    }
    bf16x8 At[4][2], B0[2][2], B1[2][2];
    const char* cA = (const char*)g.A + (size_t)cur.pm * tstepA; const char* cB = (const char*)g.Bt + (size_t)cur.pn * tstep;
    S.a_ready(cur);
    if constexpr (SP2) {
        PG8_STAGE(PG8_SB(0, 0), cB, offB); PG8_STAGE(PG8_SB(0, 1), cB + hstep, offB); PG8_STAGE(PG8_SA(0, 0), cA, offA); PG8_STAGE(PG8_SA(0, 1), cA + hstepA, offA);
        if (wr == 1) PG8_BAR;
        PG8_WAIT_V(2); PG8_BAR;
        PG8_STAGE(PG8_SB(1, 0), cB + kstep, offB); PG8_STAGE(PG8_SA(1, 0), cA + kstep, offA); PG8_STAGE(PG8_SB(1, 1), cB + hstep + kstep, offB);
        PG8_WAIT_V(6); PG8_BAR;
    } else {
        PG8_STAGE(PG8_SB(0, 0), cB, offB); PG8_STAGE(PG8_SA(0, 0), cA, offA); PG8_STAGE(PG8_SB(0, 1), cB + hstep, offB); PG8_STAGE(PG8_SA(0, 1), cA + hstepA, offA);
        if (wr == 1) PG8_BAR;
        PG8_WAIT_V(4); PG8_BAR;
        PG8_STAGE(PG8_SB(1, 0), cB + kstep, offB); PG8_STAGE(PG8_SA(1, 0), cA + kstep, offA); PG8_STAGE(PG8_SB(1, 1), cB + hstep + kstep, offB);
        PG8_WAIT_V(6); PG8_BAR;
    }
    if constexpr (Epi::ACC_INIT) E.unpack(acc, hraw);
    for (;;) {
        const bool has_next = S.next(ui + 1, nxt);
        const char* nA = has_next ? (const char*)g.A + (size_t)nxt.pm * tstepA : cA; const char* nB = has_next ? (const char*)g.Bt + (size_t)nxt.pn * tstep : cB;
        int t0 = 0;
        if constexpr (PG8_PEEL && ALIGN_EPI && SP2) { if (ui > 0) {
            const char* a2 = cA + 2 * kstep; const char* b2 = cB + 2 * kstep; const char* a3 = a2 + kstep; const char* b3 = b2 + kstep;
            PG8_LDB(B0, 0, 0); PG8_LDB(B1, 0, 1); PG8_SCHED; PG8_LDA(At, 0, 0);
            PG8_WAIT_V(24); PG8_WAIT_L(0); PG8_BAR; PG8_MMA(0, 0, At, B0); PG8_MMA(0, 1, At, B1); PG8_BAR; PG8_SCHED;
            PG8_LDA(At, 0, 1); PG8_STAGE(PG8_SB(0, 0), b2, offB); PG8_STAGE(PG8_SB(0, 1), b2 + hstep, offB); PG8_STAGE(PG8_SA(0, 0), a2, offA);
            PG8_WAIT_V(24); PG8_WAIT_L(0); PG8_BAR; PG8_MMA(1, 0, At, B0); PG8_MMA(1, 1, At, B1); PG8_BAR; PG8_SCHED;
            PG8_LDB(B0, 1, 0); PG8_LDB(B1, 1, 1); PG8_SCHED; PG8_LDA(At, 1, 0); PG8_STAGE(PG8_SA(0, 1), a2 + hstepA, offA);
            PG8_WAIT_V(24); PG8_WAIT_L(0); PG8_BAR; PG8_MMA(0, 0, At, B0); PG8_MMA(0, 1, At, B1); PG8_BAR; PG8_SCHED;
            PG8_LDA(At, 1, 1); PG8_STAGE(PG8_SB(1, 0), b3, offB); PG8_STAGE(PG8_SB(1, 1), b3 + hstep, offB); PG8_STAGE(PG8_SA(1, 0), a3, offA);
            PG8_WAIT_V(8); PG8_WAIT_L(0); PG8_BAR; PG8_MMA(1, 0, At, B0); PG8_MMA(1, 1, At, B1); PG8_BAR; PG8_SCHED;
            t0 = 2;
        } }
        for (int t = t0; t < nt; t += 2) {
            const bool last = (t == nt - 2);
            const char* a1 = cA + (size_t)(t + 1) * kstep;
            const char* a2 = last ? nA : cA + (size_t)(t + 2) * kstep; const char* b2 = last ? nB : cB + (size_t)(t + 2) * kstep;
            const char* a3 = a2 + kstep; const char* b3 = b2 + kstep;
            if (last && has_next) S.a_ready(nxt);
            if constexpr (Epi::PRE_LDS) { if (t == nt - 4) {
                int ln_; asm volatile("v_mbcnt_lo_u32_b32 %0, -1, 0\n\tv_mbcnt_hi_u32_b32 %0, -1, %0" : "=v"(ln_));
                const float* gp = E.rowss + cur.pm * BM + wr * 64 + ln_;
                __builtin_amdgcn_global_load_lds((const unsigned*)gp, (PG8_LAS unsigned*)(lds + STAGE_BYTES + wid * 512), 4, 0, 0);
                __builtin_amdgcn_global_load_lds((const unsigned*)(gp + HALF), (PG8_LAS unsigned*)(lds + STAGE_BYTES + wid * 512 + 256), 4, 0, 0); } }
            if constexpr (SP2) {
            PG8_LDB(B0, 0, 0); PG8_LDB(B1, 0, 1); PG8_SCHED; PG8_LDA(At, 0, 0); PG8_STAGE(PG8_SA(1, 1), a1 + hstepA, offA);
            PG8_WAIT_V(8); PG8_WAIT_L(0); PG8_BAR; PG8_MMA(0, 0, At, B0); PG8_MMA(0, 1, At, B1); PG8_BAR; PG8_SCHED;
            PG8_LDA(At, 0, 1); PG8_STAGE(PG8_SB(0, 0), b2, offB); PG8_STAGE(PG8_SB(0, 1), b2 + hstep, offB); PG8_STAGE(PG8_SA(0, 0), a2, offA);
            PG8_WAIT_V(8); PG8_WAIT_L(0); PG8_BAR; PG8_MMA(1, 0, At, B0); PG8_MMA(1, 1, At, B1); PG8_BAR; PG8_SCHED;
            PG8_LDB(B0, 1, 0); PG8_LDB(B1, 1, 1); PG8_SCHED; PG8_LDA(At, 1, 0); PG8_STAGE(PG8_SA(0, 1), a2 + hstepA, offA);
            PG8_WAIT_V(8); PG8_WAIT_L(0); PG8_BAR; PG8_MMA(0, 0, At, B0); PG8_MMA(0, 1, At, B1); PG8_BAR; PG8_SCHED;
            PG8_LDA(At, 1, 1); PG8_STAGE(PG8_SB(1, 0), b3, offB); PG8_STAGE(PG8_SB(1, 1), b3 + hstep, offB); PG8_STAGE(PG8_SA(1, 0), a3, offA);
            PG8_WAIT_V(8); PG8_WAIT_L(0); PG8_BAR; PG8_MMA(1, 0, At, B0); PG8_MMA(1, 1, At, B1); PG8_BAR; PG8_SCHED;
            } else {
            PG8_LDB(B0, 0, 0); PG8_SCHED; PG8_LDA(At, 0, 0); PG8_STAGE(PG8_SA(1, 1), a1 + hstepA, offA);
            PG8_WAIT_L(8); PG8_BAR; PG8_WAIT_L(0); PG8_MMA(0, 0, At, B0); PG8_BAR; PG8_SCHED;
            PG8_LDB(B1, 0, 1); PG8_STAGE(PG8_SB(0, 0), b2, offB);
            PG8_BAR; PG8_WAIT_L(0); PG8_MMA(0, 1, At, B1); PG8_BAR;
            PG8_LDA(At, 0, 1); PG8_STAGE(PG8_SA(0, 0), a2, offA);
            PG8_BAR; PG8_WAIT_L(0); PG8_MMA(1, 0, At, B0); PG8_BAR; PG8_SCHED;
            PG8_STAGE(PG8_SB(0, 1), b2 + hstep, offB);
            PG8_WAIT_V(6); PG8_BAR; PG8_MMA(1, 1, At, B1); PG8_BAR;
            PG8_LDB(B0, 1, 0); PG8_SCHED; PG8_LDA(At, 1, 0); PG8_STAGE(PG8_SA(0, 1), a2 + hstepA, offA);
            PG8_WAIT_L(8); PG8_BAR; PG8_WAIT_L(0); PG8_MMA(0, 0, At, B0); PG8_BAR; PG8_SCHED;
            PG8_LDB(B1, 1, 1); PG8_STAGE(PG8_SB(1, 0), b3, offB);
            PG8_BAR; PG8_WAIT_L(0); PG8_MMA(0, 1, At, B1); PG8_BAR;
            PG8_LDA(At, 1, 1); PG8_STAGE(PG8_SA(1, 0), a3, offA);
            PG8_BAR; PG8_WAIT_L(0); PG8_MMA(1, 0, At, B0); PG8_BAR; PG8_SCHED;
            PG8_STAGE(PG8_SB(1, 1), b3 + hstep, offB);
            PG8_WAIT_V(6); PG8_BAR; PG8_MMA(1, 1, At, B1); PG8_BAR;
            }
        }
        if constexpr (ALIGN_EPI) { if (wr == 0) PG8_BAR; }
        if constexpr (PG8_PEEL && ALIGN_EPI && SP2) { if (has_next) PG8_STAGE(PG8_SA(1, 1), nA + kstep + hstepA, offA); }
        if constexpr (Epi::ACC_INIT) {
            u32x4 hr[4][2];
            PG8_SCHED; if (has_next) E.load_h_half(hr, nxt, wr, wc, 0); PG8_SCHED;
            E.half(acc, cur, wr, wc, 0); PG8_SCHED;
            if (has_next) { E.unpack_half(acc, hr, 0); PG8_SCHED; E.load_h_half(hr, nxt, wr, wc, 1); } PG8_SCHED;
            E.half(acc, cur, wr, wc, 1); PG8_SCHED;
            if (has_next) E.unpack_half(acc, hr, 1); PG8_SCHED;
            S.done(cur);
        } else
        if constexpr (!Epi::AFTER_DRAIN) { E(acc, cur, wr, wc, (const PG8_LAS float*)(lds + STAGE_BYTES) + wid * 128); S.done(cur); }
        if (!has_next) break;
        if constexpr (Epi::ACC_INIT) { }
        else {
#pragma unroll
        for (int a = 0; a < 2; ++a)
#pragma unroll
            for (int b = 0; b < 2; ++b)
#pragma unroll
                for (int m = 0; m < 4; ++m)
#pragma unroll
                    for (int n = 0; n < 2; ++n) acc[a][b][m][n] = (f32x4){0.f, 0.f, 0.f, 0.f};
        }
        cur = nxt; cA = nA; cB = nB; ++ui;
        if constexpr (ALIGN_EPI) { if (wr == 1) PG8_BAR; }
    }
    { int ln_; asm volatile("v_mbcnt_lo_u32_b32 %0, -1, 0\n\tv_mbcnt_hi_u32_b32 %0, -1, %0" : "=v"(ln_)); tid_io = wid * 64 + ln_; }
    PG8_WAIT_V(0);
    if constexpr (!ALIGN_EPI) { if (wr == 0) PG8_BAR; }
    PG8_BAR;
    if constexpr (Epi::AFTER_DRAIN) { E.fused(acc, cur, wr, wc, fr, fq, lds, wid, lane); S.done(cur); }
#undef PG8_SA
#undef PG8_SB
#undef PG8_STAGE
#undef PG8_LDA
#undef PG8_LDB
#undef PG8_MMA
#undef PG8_WAIT_V
#undef PG8_WAIT_L
#undef PG8_BAR
#undef PG8_SCHED
}
}

namespace pg8 {
constexpr int MP_ROWS = 32768;
typedef unsigned u32x2 __attribute__((ext_vector_type(2)));
__device__ __forceinline__ unsigned pkbf(float lo, float hi) { typedef float f2_t __attribute__((ext_vector_type(2))); typedef __bf16 b2_t __attribute__((ext_vector_type(2))); f2_t v = {lo, hi}; b2_t b = __builtin_convertvector(v, b2_t); return __builtin_bit_cast(unsigned, b); }
__device__ __forceinline__ u32x4 pk8(f32x4 a, f32x4 b) { u32x4 w; w.x = pkbf(a[0], a[1]); w.y = pkbf(a[2], a[3]); w.z = pkbf(b[0], b[1]); w.w = pkbf(b[2], b[3]); return w; }
__device__ __forceinline__ float silu_f(float x) { return x * __builtin_amdgcn_rcpf(1.0f + __builtin_amdgcn_exp2f(-1.4426950408889634f * x)); }

#define PG8_EPI_DRIVER \
    __device__ __forceinline__ void operator()(const f32x4 (&acc)[2][2][4][2], const Unit& u, int wr, int wc, const PG8_LAS float* pl) const { \
        int ln_; asm volatile("v_mbcnt_lo_u32_b32 %0, -1, 0\n\tv_mbcnt_hi_u32_b32 %0, -1, %0" : "=v"(ln_)); const int fr = ln_ & 15, fq = ln_ >> 4;     \
        const int cb = u.pn * BM + wc * 32 + 8 * fq, rb = u.pm * BM + wr * 64 + fr; \
        float pre[8]; \
        _Pragma("unroll") for (int i = 0; i < 8; ++i) pre[i] = PRE_LDS ? __builtin_amdgcn_rsqf(pl[(i >> 2) * 64 + (i & 3) * 16 + fr] * (1.0f / 1024.0f) + 1e-6f) : rowpre(rb + (i >> 2) * HALF + (i & 3) * 16);     \
        _Pragma("unroll") for (int ai = 0; ai < 2; ++ai) \
        _Pragma("unroll") for (int m = 0; m < 4; ++m) { \
            const int r = rb + ai * HALF + m * 16; float ss = 0.f; \
            _Pragma("unroll") for (int bj = 0; bj < 2; ++bj) ss += apply(r, cb + bj * HALF, acc[ai][bj][m][0], acc[ai][bj][m][1], pre[ai * 4 + m]); \
            if (HAS_POST) { ss += __shfl_xor(ss, 16); ss += __shfl_xor(ss, 32); post(r, ss, fq == 0); } \
            if ((m & (FENCE - 1)) == FENCE - 1) asm volatile("" ::: "memory"); } \
    }

#define PG8_RES_HELPERS \
    __device__ __forceinline__ void load_h(u32x4 (&hraw)[2][4][2], const Unit& u, int wr, int wc) const { \
        int ln_; asm volatile("v_mbcnt_lo_u32_b32 %0, -1, 0\n\tv_mbcnt_hi_u32_b32 %0, -1, %0" : "=v"(ln_)); const int fr = ln_ & 15, fq = ln_ >> 4; \
        const bf16_t* hp = hb + (size_t)(u.pm * BM + wr * 64 + fr) * 1024 + u.pn * BM + wc * 32 + 8 * fq; \
        _Pragma("unroll") for (int ai = 0; ai < 2; ++ai) _Pragma("unroll") for (int m = 0; m < 4; ++m) _Pragma("unroll") for (int bj = 0; bj < 2; ++bj) \
            hraw[ai][m][bj] = *(const u32x4*)(hp + (size_t)(ai * HALF + m * 16) * 1024 + bj * HALF); } \
    __device__ __forceinline__ void load_h_half(u32x4 (&hr)[4][2], const Unit& u, int wr, int wc, int ai) const { \
        int ln_; asm volatile("v_mbcnt_lo_u32_b32 %0, -1, 0\n\tv_mbcnt_hi_u32_b32 %0, -1, %0" : "=v"(ln_)); const int fr = ln_ & 15, fq = ln_ >> 4; \
        const bf16_t* hp = hb + (size_t)(u.pm * BM + wr * 64 + fr + ai * HALF) * 1024 + u.pn * BM + wc * 32 + 8 * fq; \
        _Pragma("unroll") for (int m = 0; m < 4; ++m) _Pragma("unroll") for (int bj = 0; bj < 2; ++bj) hr[m][bj] = *(const u32x4*)(hp + (size_t)(m * 16) * 1024 + bj * HALF); } \
    __device__ __forceinline__ void unpack_half(f32x4 (&acc)[2][2][4][2], const u32x4 (&hr)[4][2], int ai) const { \
        _Pragma("unroll") for (int m = 0; m < 4; ++m) _Pragma("unroll") for (int bj = 0; bj < 2; ++bj) { const u32x4 hw = hr[m][bj]; \
            acc[ai][bj][m][0] = (f32x4){__uint_as_float(hw.x << 16), __uint_as_float(hw.x & 0xffff0000u), __uint_as_float(hw.y << 16), __uint_as_float(hw.y & 0xffff0000u)}; \
            acc[ai][bj][m][1] = (f32x4){__uint_as_float(hw.z << 16), __uint_as_float(hw.z & 0xffff0000u), __uint_as_float(hw.w << 16), __uint_as_float(hw.w & 0xffff0000u)}; } } \
    __device__ __forceinline__ void unpack(f32x4 (&acc)[2][2][4][2], const u32x4 (&hraw)[2][4][2]) const { \
        _Pragma("unroll") for (int ai = 0; ai < 2; ++ai) _Pragma("unroll") for (int m = 0; m < 4; ++m) _Pragma("unroll") for (int bj = 0; bj < 2; ++bj) { const u32x4 hw = hraw[ai][m][bj]; \
            acc[ai][bj][m][0] = (f32x4){__uint_as_float(hw.x << 16), __uint_as_float(hw.x & 0xffff0000u), __uint_as_float(hw.y << 16), __uint_as_float(hw.y & 0xffff0000u)}; \
            acc[ai][bj][m][1] = (f32x4){__uint_as_float(hw.z << 16), __uint_as_float(hw.z & 0xffff0000u), __uint_as_float(hw.w << 16), __uint_as_float(hw.w & 0xffff0000u)}; } }

struct EpiAB {
    static constexpr bool PERM = true, AFTER_DRAIN = false, HAS_POST = false, PRE_LDS = true, ACC_INIT = false;
    bf16_t* Z; const float* rowss; const float* ropec; const float* ropes;
    static constexpr int FENCE = 4;
    __device__ __forceinline__ void post(int, float, bool) const {}
    __device__ __forceinline__ float rowpre(int r) const { return __builtin_amdgcn_rsqf(rowss[r] * (1.0f / 1024.0f) + 1e-6f); }
    __device__ __forceinline__ float apply(int r, int col, f32x4 a0, f32x4 a1, float rstd) const {
        const int pn = col >> 8;
        bf16_t* zrow = Z + (size_t)r * 4096;
        if (pn < 4) {
            const bool prompt = r < MP_ROWS; const int ic = prompt ? (r & 127) : (r & 7); const int trow = prompt ? (r & 2047) : 2048 + (r & 7);
            const int d0 = 16 * ((col & 127) >> 5) + 4 * ((col >> 3) & 3), head = (col >> 7) & 3;
            const f32x4 cs = *(const f32x4*)(ropec + trow * 64 + d0), sn = *(const f32x4*)(ropes + trow * 64 + d0);
            const float l2g = head == 0 ? -0.04580368961312479f : head == 1 ? -0.02272007650008353f : head == 2 ? -0.011315313227834146f : -0.005646563141142063f;
            const float e = (float)(ic + 1) * l2g;
            const float sc = rstd * (pn < 2 ? __builtin_amdgcn_exp2f(e) * 0.08838834764831845f : __builtin_amdgcn_exp2f(-e));
            const f32x4 x1 = a0 * sc, x2 = a1 * sc;
            const f32x4 o1 = x1 * cs - x2 * sn, o2 = x2 * cs + x1 * sn;
            u32x2 w1, w2; w1.x = pkbf(o1[0], o1[1]); w1.y = pkbf(o1[2], o1[3]); w2.x = pkbf(o2[0], o2[1]); w2.y = pkbf(o2[2], o2[3]);
            bf16_t* zp = zrow + (col & ~127) + d0;
            *(u32x2*)zp = w1; *(u32x2*)(zp + 64) = w2;
        } else {
            f32x4 v0 = a0 * rstd, v1 = a1 * rstd;
            if (pn >= 8) { f32x2 a = gelu_pk((f32x2){v0[0], v0[1]}), b = gelu_pk((f32x2){v0[2], v0[3]}), c = gelu_pk((f32x2){v1[0], v1[1]}), d = gelu_pk((f32x2){v1[2], v1[3]});
                v0 = (f32x4){a.x, a.y, b.x, b.y}; v1 = (f32x4){c.x, c.y, d.x, d.y}; }
            else if (pn >= 6) { v0 = (f32x4){silu_f(v0[0]), silu_f(v0[1]), silu_f(v0[2]), silu_f(v0[3])}; v1 = (f32x4){silu_f(v1[0]), silu_f(v1[1]), silu_f(v1[2]), silu_f(v1[3])}; }
            *(u32x4*)(zrow + col) = pk8(v0, v1);
        }
        return 0.f;
    }
    PG8_EPI_DRIVER
};
struct EpiRes {
    static constexpr bool PERM = true, AFTER_DRAIN = false, HAS_POST = true, PRE_LDS = false, ACC_INIT = true;
    bf16_t* hb; float* rowss_out; const float* bias;
    static constexpr int FENCE = 4;
    __device__ __forceinline__ void post(int r, float ss, bool lead) const { if (lead) atomicAdd(rowss_out + r, ss); }
    __device__ __forceinline__ float rowpre(int) const { return 0.f; }
    __device__ __forceinline__ float apply(int r, int col, f32x4 a0, f32x4 a1, float) const {
        bf16_t* hp = hb + (size_t)r * 1024 + col;
        const u32x4 hw = *(const u32x4*)hp;
        f32x4 v0 = a0 + (f32x4){__uint_as_float(hw.x << 16), __uint_as_float(hw.x & 0xffff0000u), __uint_as_float(hw.y << 16), __uint_as_float(hw.y & 0xffff0000u)};
        f32x4 v1 = a1 + (f32x4){__uint_as_float(hw.z << 16), __uint_as_float(hw.z & 0xffff0000u), __uint_as_float(hw.w << 16), __uint_as_float(hw.w & 0xffff0000u)};
        if (bias) { v0 += *(const f32x4*)(bias + col); v1 += *(const f32x4*)(bias + col + 4); }
        *(u32x4*)hp = pk8(v0, v1);
        return (v0[0] * v0[0] + v0[1] * v0[1]) + (v0[2] * v0[2] + v0[3] * v0[3]) + (v1[0] * v1[0] + v1[1] * v1[1]) + (v1[2] * v1[2] + v1[3] * v1[3]);
    }
    PG8_RES_HELPERS
    __device__ __forceinline__ void half(const f32x4 (&acc)[2][2][4][2], const Unit& u, int wr, int wc, int ai) const {
        int ln_; asm volatile("v_mbcnt_lo_u32_b32 %0, -1, 0\n\tv_mbcnt_hi_u32_b32 %0, -1, %0" : "=v"(ln_)); const int fr = ln_ & 15, fq = ln_ >> 4;
        const int cb = u.pn * BM + wc * 32 + 8 * fq, rb = u.pm * BM + wr * 64 + fr;
        f32x4 bb[2][2];
#pragma unroll
        for (int bj = 0; bj < 2; ++bj) { bb[bj][0] = bias ? *(const f32x4*)(bias + cb + bj * HALF) : (f32x4){0.f, 0.f, 0.f, 0.f}; bb[bj][1] = bias ? *(const f32x4*)(bias + cb + bj * HALF + 4) : (f32x4){0.f, 0.f, 0.f, 0.f}; }
        {
#pragma unroll
            for (int m = 0; m < 4; ++m) { const int r = rb + ai * HALF + m * 16; float ss = 0.f;
#pragma unroll
                for (int bj = 0; bj < 2; ++bj) { const f32x4 v0 = acc[ai][bj][m][0] + bb[bj][0], v1 = acc[ai][bj][m][1] + bb[bj][1];
                    *(u32x4*)(hb + (size_t)r * 1024 + cb + bj * HALF) = pk8(v0, v1);
                    ss += (v0[0] * v0[0] + v0[1] * v0[1]) + (v0[2] * v0[2] + v0[3] * v0[3]) + (v1[0] * v1[0] + v1[1] * v1[1]) + (v1[2] * v1[2] + v1[3] * v1[3]); }
                ss += __shfl_xor(ss, 16); ss += __shfl_xor(ss, 32); post(r, ss, fq == 0); }
        }
    }
};
struct EpiResB {
    static constexpr bool PERM = true, AFTER_DRAIN = false, HAS_POST = true, PRE_LDS = false, ACC_INIT = false;
    bf16_t* hb; float* rowss_out; const float* bias;
    static constexpr int FENCE = 4;
    __device__ __forceinline__ void post(int r, float ss, bool lead) const { if (lead) atomicAdd(rowss_out + r, ss); }
    __device__ __forceinline__ float rowpre(int) const { return 0.f; }
    __device__ __forceinline__ float apply(int r, int col, f32x4 a0, f32x4 a1, float) const {
        bf16_t* hp = hb + (size_t)r * 1024 + col;
        const u32x4 hw = *(const u32x4*)hp;
        f32x4 v0 = a0 + (f32x4){__uint_as_float(hw.x << 16), __uint_as_float(hw.x & 0xffff0000u), __uint_as_float(hw.y << 16), __uint_as_float(hw.y & 0xffff0000u)};
        f32x4 v1 = a1 + (f32x4){__uint_as_float(hw.z << 16), __uint_as_float(hw.z & 0xffff0000u), __uint_as_float(hw.w << 16), __uint_as_float(hw.w & 0xffff0000u)};
        v0 += *(const f32x4*)(bias + col); v1 += *(const f32x4*)(bias + col + 4);
        *(u32x4*)hp = pk8(v0, v1);
        return (v0[0] * v0[0] + v0[1] * v0[1]) + (v0[2] * v0[2] + v0[3] * v0[3]) + (v1[0] * v1[0] + v1[1] * v1[1]) + (v1[2] * v1[2] + v1[3] * v1[3]);
    }
    PG8_EPI_DRIVER
};
struct EpiUp {
    static constexpr bool PERM = true, AFTER_DRAIN = false, HAS_POST = false, PRE_LDS = true, ACC_INIT = false;
    bf16_t* O; const float* rowss;
    static constexpr int FENCE = 4;
    __device__ __forceinline__ void post(int, float, bool) const {}
    __device__ __forceinline__ float rowpre(int r) const { return __builtin_amdgcn_rsqf(rowss[r] * (1.0f / 1024.0f) + 1e-6f); }
    __device__ __forceinline__ float apply(int r, int col, f32x4 a0, f32x4 a1, float rstd) const {
        f32x4 v0 = a0 * rstd, v1 = a1 * rstd;
#pragma unroll
        for (int e = 0; e < 4; ++e) { const float a = fmaxf(v0[e], 0.f), b = fmaxf(v1[e], 0.f); v0[e] = a * a; v1[e] = b * b; }
        *(u32x4*)(O + (size_t)r * 4096 + col) = pk8(v0, v1);
        return 0.f;
    }
    PG8_EPI_DRIVER
};
struct EpiQKV {
    static constexpr bool PERM = true, AFTER_DRAIN = false, HAS_POST = false, PRE_LDS = true, ACC_INIT = false;
    bf16_t* O; const float* rowss; const float* bias; float* ckp; float* cks;
    static constexpr int FENCE = 4;
    __device__ __forceinline__ void post(int, float, bool) const {}
    __device__ __forceinline__ float rowpre(int r) const { return __builtin_amdgcn_rsqf(rowss[r] * (1.0f / 1024.0f) + 1e-6f); }
    __device__ __forceinline__ float apply(int r, int col, f32x4 a0, f32x4 a1, float rstd) const {
        const float qs = col < 1024 ? 0.125f * 1.4426950408889634f : 1.0f;
        const f32x4 v0 = (a0 * rstd + *(const f32x4*)(bias + col)) * qs, v1 = (a1 * rstd + *(const f32x4*)(bias + col + 4)) * qs;
        *(u32x4*)(O + (size_t)r * 4096 + col) = pk8(v0, v1);
        if (col >= 1024) {
            float* dst = nullptr; const int isv = (col >> 7) & 1, cc = col & 127;
            if (r < MP_ROWS) { const int t = r & 2047; if (t >= 1920) dst = ckp + (size_t)isv * 262144 + (size_t)((r >> 11) * 128 + t - 1920) * 128 + cc; }
            else { const int s = r - MP_ROWS; dst = cks + (size_t)isv * 2097152 + (size_t)((s >> 3) * 128 + 120 + (s & 7)) * 128 + cc; }
            if (dst) { *(f32x4*)dst = v0; *(f32x4*)(dst + 4) = v1; }
        }
        return 0.f;
    }
    PG8_EPI_DRIVER
};
struct EpiResFin {
    static constexpr bool PERM = true, AFTER_DRAIN = false, PRE_LDS = false, ACC_INIT = false;
    const bf16_t* hb; float* rowss; unsigned* cnt; const float* gfin; float* y; unsigned* tmo;
    __device__ __forceinline__ void operator()(f32x4 (&acc)[2][2][4][2], const Unit& u, int wr, int wc, const PG8_LAS float*) const {
        int ln_; asm volatile("v_mbcnt_lo_u32_b32 %0, -1, 0\n\tv_mbcnt_hi_u32_b32 %0, -1, %0" : "=v"(ln_)); const int fr = ln_ & 15, fq = ln_ >> 4;
        const int cb = u.pn * BM + wc * 32 + 8 * fq, rb = u.pm * BM + wr * 64 + fr;
#pragma unroll
        for (int ai = 0; ai < 2; ++ai)
#pragma unroll
            for (int m = 0; m < 4; ++m) { const int r = rb + ai * HALF + m * 16; float ss = 0.f;
#pragma unroll
                for (int bj = 0; bj < 2; ++bj) { const u32x4 hw = *(const u32x4*)(hb + (size_t)r * 1024 + cb + bj * HALF);
                    const f32x4 v0 = acc[ai][bj][m][0] + (f32x4){__uint_as_float(hw.x << 16), __uint_as_float(hw.x & 0xffff0000u), __uint_as_float(hw.y << 16), __uint_as_float(hw.y & 0xffff0000u)};
                    const f32x4 v1 = acc[ai][bj][m][1] + (f32x4){__uint_as_float(hw.z << 16), __uint_as_float(hw.z & 0xffff0000u), __uint_as_float(hw.w << 16), __uint_as_float(hw.w & 0xffff0000u)};
                    acc[ai][bj][m][0] = v0; acc[ai][bj][m][1] = v1;
                    ss += (v0[0] * v0[0] + v0[1] * v0[1]) + (v0[2] * v0[2] + v0[3] * v0[3]) + (v1[0] * v1[0] + v1[1] * v1[1]) + (v1[2] * v1[2] + v1[3] * v1[3]); }
                ss += __shfl_xor(ss, 16); ss += __shfl_xor(ss, 32);
                if (fq == 0) atomicAdd(rowss + r, ss); }
        asm volatile("s_waitcnt vmcnt(0)" ::: "memory");
        unsigned* cw = cnt + 64 * u.pm;
        if (fr == 0 && fq == 0) __hip_atomic_fetch_add(cw, 1u, __ATOMIC_RELAXED, __HIP_MEMORY_SCOPE_AGENT);
        { unsigned sp = 0;
          while ((unsigned)__builtin_amdgcn_readfirstlane((int)__hip_atomic_load(cw, __ATOMIC_RELAXED, __HIP_MEMORY_SCOPE_AGENT)) < 32u) {
              __builtin_amdgcn_s_sleep(2); if (++sp > (1u << 20)) { if (fr == 0 && fq == 0) __hip_atomic_store(tmo, 1u, __ATOMIC_RELAXED, __HIP_MEMORY_SCOPE_AGENT); break; } } }
        float rs8[8];
#pragma unroll
        for (int i = 0; i < 8; ++i) rs8[i] = __hip_atomic_load(rowss + rb + (i >> 2) * HALF + (i & 3) * 16, __ATOMIC_RELAXED, __HIP_MEMORY_SCOPE_AGENT);
        f32x4 gg[2][2];
#pragma unroll
        for (int bj = 0; bj < 2; ++bj) { gg[bj][0] = *(const f32x4*)(gfin + (cb & 1023) + bj * HALF); gg[bj][1] = *(const f32x4*)(gfin + (cb & 1023) + bj * HALF + 4); }
#pragma unroll
        for (int ai = 0; ai < 2; ++ai)
#pragma unroll
            for (int m = 0; m < 4; ++m) { const int r = rb + ai * HALF + m * 16; const float rstd = 1.0f / sqrtf(rs8[ai * 4 + m] * (1.0f / 1024.0f) + 1e-6f);
#pragma unroll
                for (int bj = 0; bj < 2; ++bj) { float* yp = y + (size_t)r * 1024 + cb + bj * HALF;
                    *(f32x4*)yp = acc[ai][bj][m][0] * rstd * gg[bj][0]; *(f32x4*)(yp + 4) = acc[ai][bj][m][1] * rstd * gg[bj][1]; } }
    }
};
struct GroupOrder {
    int pm0, npm, nN, nl, rk;
    __device__ __forceinline__ bool next(int i, Unit& u) const {
        const int L = i * nl + rk; if (L >= npm * nN) return false;
        const int blk = L / (8 * nN), rem = L - blk * 8 * nN;
        u.pm = pm0 + 8 * blk + (rem & 7); u.pn = rem >> 3; return true;
    }
    __device__ __forceinline__ void a_ready(const Unit&) const {}
    __device__ __forceinline__ void done(const Unit&) const {}
};
}
#ifndef PG8_SP2
#define PG8_SP2 true
#endif
#ifndef PG8_ALIGN
#define PG8_ALIGN true
#endif
#define GAS __attribute__((address_space(1)))
#define LAS __attribute__((address_space(3)))
typedef unsigned short bf16;
typedef unsigned v4u __attribute__((ext_vector_type(4)));
typedef float f32x4 __attribute__((ext_vector_type(4)));
typedef short bf16x8 __attribute__((ext_vector_type(8)));
typedef GAS unsigned gu32;
typedef GAS unsigned long long gu64;
#define RLX_AGENT __ATOMIC_RELAXED, __HIP_MEMORY_SCOPE_AGENT
#define LDS_WAIT() asm volatile("s_waitcnt lgkmcnt(0)" ::: "memory")
#define VM_WAIT() asm volatile("s_waitcnt vmcnt(0)" ::: "memory")
__device__ __forceinline__ unsigned long long rt() { return __builtin_amdgcn_s_memrealtime(); }
__device__ __forceinline__ unsigned f2bf(float f) { unsigned u = __builtin_bit_cast(unsigned, f); return (u + 0x7fffu + ((u >> 16) & 1u)) >> 16; }
__device__ __forceinline__ unsigned pk2(float lo, float hi) { return f2bf(lo) | (f2bf(hi) << 16); }

#define XB_TMO      128
#define XB_XCNT(j)  (256  + 64 * (j))
#define XB_XSUB(j)  (1280 + 64 * (j))
#define XB_XGEN(j)  (2304 + 64 * (j))
#define XB_TOP      3328
#define XB_TOPGEN   3392
#define XCD_BAR_WORDS 3456
#define XB_SPIN_CAP (1u << 18)

__device__ __forceinline__ unsigned xb_ld(unsigned* p)              { return __hip_atomic_load(p, __ATOMIC_RELAXED, __HIP_MEMORY_SCOPE_AGENT); }
__device__ __forceinline__ unsigned xb_add(unsigned* p, unsigned v) { return __hip_atomic_fetch_add(p, v, __ATOMIC_RELAXED, __HIP_MEMORY_SCOPE_AGENT); }
__device__ __forceinline__ unsigned xb_xcc_id() { return (unsigned)__builtin_amdgcn_s_getreg((3 << 11) | 20) & 0xFu; }
#define XB_SPIN(cond, bar) do { unsigned _sp = 0; while (cond) { __builtin_amdgcn_s_sleep(1); \
    if ((++_sp & 255u) == 0u) { if (xb_ld(&(bar)[XB_TMO])) break; if (_sp > XB_SPIN_CAP) { atomicAdd(&(bar)[XB_TMO], 1u); break; } } } } while (0)

struct XcdBarrier {
    unsigned* bar; unsigned x;
    volatile LAS unsigned* st;
};

__device__ __forceinline__ XcdBarrier xcd_barrier_post(unsigned* bar, volatile LAS unsigned* st) {
    XcdBarrier b; b.bar = bar; b.x = xb_xcc_id(); b.st = st;
    if (threadIdx.x == 0) st[2] = xb_add(&bar[XB_XCNT(b.x)], 1u);
    return b;
}
__device__ __forceinline__ void xcd_barrier_complete(unsigned* bar, unsigned x, unsigned& nloc, unsigned& nx, unsigned& gidx) {
    const unsigned G = gridDim.x * gridDim.y * gridDim.z;
    unsigned sum, cnt, mine, sp = 0u;
    for (;;) {
        sum = 0u; cnt = 0u; mine = 0u;
#pragma unroll
        for (unsigned j = 0; j < 16; ++j) { const unsigned c = xb_ld(&bar[XB_XCNT(j)]); sum += c; cnt += (c > 0u) ? 1u : 0u; mine = (j == x) ? c : mine; }
        if (sum == G) break;
        __builtin_amdgcn_s_sleep(1);
        if ((++sp & 255u) == 0u) { if (xb_ld(&bar[XB_TMO])) break; if (sp > XB_SPIN_CAP) { atomicAdd(&bar[XB_TMO], 1u); break; } }
    }
    nloc = mine > 0u ? mine : 1u; nx = cnt > 0u ? cnt : 1u;
    gidx = 0u;
#pragma unroll
    for (unsigned j = 0; j < 16; ++j) if (j < x && xb_ld(&bar[XB_XCNT(j)]) > 0u) ++gidx;
}

__device__ __forceinline__ void xcd_barrier(const XcdBarrier& b) {
    asm volatile("s_waitcnt vmcnt(0)" ::: "memory");
    __syncthreads();
    if (threadIdx.x == 0) {
        unsigned* bar = b.bar;
        __builtin_amdgcn_s_waitcnt(0);
        unsigned nloc = b.st[0], nx = b.st[1];
        if (nloc == 0u) { unsigned gidx; xcd_barrier_complete(bar, b.x, nloc, nx, gidx); b.st[0] = nloc; b.st[1] = nx; b.st[3] = gidx; }
        const unsigned old = xb_add(&bar[XB_XSUB(b.x)], 1u);
        const unsigned gen = old / nloc;
        if (old + 1u == (gen + 1u) * nloc) {
            __builtin_amdgcn_fence(__ATOMIC_RELEASE, "agent");
            asm volatile("s_waitcnt vmcnt(0)" ::: "memory");
            const unsigned og = xb_add(&bar[XB_TOP], 1u);
            const unsigned tg = og / nx;
            if (og + 1u == (tg + 1u) * nx) xb_add(&bar[XB_TOPGEN], 1u);
            else XB_SPIN(xb_ld(&bar[XB_TOPGEN]) == tg, bar);
            __builtin_amdgcn_fence(__ATOMIC_ACQUIRE, "agent");
            xb_add(&bar[XB_XGEN(b.x)], 1u);
            asm volatile("s_waitcnt vmcnt(0)" ::: "memory");
        } else {
            XB_SPIN(xb_ld(&bar[XB_XGEN(b.x)]) == gen, bar);
            __builtin_amdgcn_fence(__ATOMIC_ACQUIRE, "agent");
            asm volatile("s_waitcnt vmcnt(0)" ::: "memory");
        }
    }
    __syncthreads();
}

#define XB_VSUB(j)  (3456 + 64 * (j))
#define XB_VGEN(j)  (5504 + 64 * (j))
#define XCD_BAR_WORDS_V 7552
__device__ __forceinline__ void group_barrier(unsigned* bar, volatile LAS unsigned* gst, int tid_in) {
    asm volatile("s_waitcnt vmcnt(0)" ::: "memory");
    __syncthreads();
    if (tid_in == 0) {
        __builtin_amdgcn_s_waitcnt(0);
        const unsigned nloc = gst[0], slot = gst[4];
        const unsigned old = xb_add(&bar[XB_VSUB(slot)], 1u);
        const unsigned gen = old / nloc;
        if (old + 1u == (gen + 1u) * nloc) xb_add(&bar[XB_VGEN(slot)], 1u);
        else XB_SPIN(xb_ld(&bar[XB_VGEN(slot)]) == gen, bar);
        __builtin_amdgcn_fence(__ATOMIC_ACQUIRE, "agent");
        asm volatile("s_waitcnt vmcnt(0)" ::: "memory");
    }
    __syncthreads();
}

constexpr int NWAVES = 8;
constexpr int D = 1024, SEQ = 2048, NBATCH = 16, MP = NBATCH * SEQ, NDB = 128, DSEQ = 8, MS = NDB * DSEQ, M = MP + MS, FF = 4096, NZ = 3072, NQKV = 1280;
constexpr int BP = 4096;
constexpr int ROPE_ROWS = SEQ + DSEQ;
constexpr float LOG2E = 1.4426950408889634f;

constexpr size_t MiB = 1u << 20;
constexpr size_t WS_CTL = 0, CTL_ZERO_BYTES = 1 * MiB;
constexpr size_t WS_ROWSS = 256 * 1024;
static_assert(WS_ROWSS + 5 * (size_t)M * 4 <= CTL_ZERO_BYTES && (16384 + 64 * 132) * 4 <= (int)WS_ROWSS, "rowss and the arrival words inside the zeroed region");
constexpr size_t WS_WSB = 4 * MiB;
constexpr size_t WS_ROPE = 2 * MiB;
constexpr size_t WS_WIN = 5 * MiB, WS_WO0 = 11 * MiB, WS_WUP0 = 13 * MiB, WS_WDN0 = 21 * MiB, WS_WQKV = 29 * MiB, WS_WO1 = 32 * MiB, WS_WUP1 = 34 * MiB, WS_WDN1 = 42 * MiB;
constexpr size_t WS_HB = 50 * MiB;
constexpr size_t WS_BIG = 116 * MiB;
constexpr size_t WS_SIMG = 384 * MiB;
constexpr size_t WS_Z = WS_BIG, WS_OC = WS_BIG + 3072 * 2, WS_QKV = WS_BIG, WS_AO = WS_BIG + 3072 * 2, WS_END = 416 * MiB;
static_assert(WS_HB + (size_t)M * D * 2 <= WS_BIG && WS_BIG + (size_t)M * BP * 2 <= WS_SIMG && WS_SIMG + 32 * MiB <= WS_END && NZ <= 3072 && NQKV <= 3072 && 3072 + D <= BP && FF == BP, "d_ws map");
constexpr int CW_FIN = 16384;
constexpr int CW_BAR = 4096;
constexpr size_t OUT_Y = 0, OUT_RETP = (size_t)M * D, OUT_RETS = OUT_RETP + (size_t)NBATCH * 4 * 128 * 128, OUT_GMS = OUT_RETS + (size_t)NDB * 4 * 128 * 128, OUT_CKP = OUT_GMS + (size_t)NDB * DSEQ * 512,
                 OUT_CVP = OUT_CKP + (size_t)NBATCH * 128 * 128, OUT_CKS = OUT_CVP + (size_t)NBATCH * 128 * 128, OUT_CVS = OUT_CKS + (size_t)NDB * 128 * 128, OUT_END = OUT_CVS + (size_t)NDB * 128 * 128;
static_assert(OUT_CVP - OUT_CKP == 262144 && OUT_CVS - OUT_CKS == 2097152, "EpiQKV's v-cache offsets");
constexpr int RING_OFF = 0, SCR_BYTES = 143360, LDSCTL_OFF = SCR_BYTES, MISC_OFF = LDSCTL_OFF + 320, LDS_BYTES = 147456;

__device__ __forceinline__ float bf2f(unsigned short b) { return __uint_as_float(((unsigned)b) << 16); }
__device__ __forceinline__ float wave_sum(float v) {
#pragma unroll
    for (int o = 1; o < 64; o <<= 1) v += __shfl_xor(v, o);
    return v;
}
__device__ __forceinline__ int win_destrow(int n) {
    if (n >= 1024) return n;
    const int d = n & 127, nb = d >> 6, dl = d & 63, wc = dl >> 4, fq = (dl >> 2) & 3, e = dl & 3;
    return (n & ~127) + 32 * wc + 8 * fq + 4 * nb + e;
}
template <int MODE> __device__ __forceinline__ void p0_transpose_item(const float* W, int K, int N, bf16* WT, const float* gain, LAS float* scr, int item, int lane) {
    const int nblk = N / 32, kb = item / nblk, nb = item % nblk, k0 = 64 * kb, n0 = 32 * nb;
    float wv[32];
#pragma unroll
    for (int i = 0; i < 32; ++i) wv[i] = W[(size_t)(k0 + 2 * i + (lane >> 5)) * N + n0 + (lane & 31)];
    if (gain) {
#pragma unroll
        for (int i = 0; i < 32; ++i) wv[i] *= gain[k0 + 2 * i + (lane >> 5)]; }
#pragma unroll
    for (int i = 0; i < 32; ++i) scr[(2 * i + (lane >> 5)) * 33 + (lane & 31)] = wv[i];
    LDS_WAIT(); asm volatile("" ::: "memory");
    const int c = lane & 7;
#pragma unroll
    for (int j = 0; j < 4; ++j) { const int n = (lane >> 3) + 8 * j; const LAS float* s = scr + (8 * c) * 33 + n;
        v4u o; o.x = pk2(s[0 * 33], s[1 * 33]); o.y = pk2(s[2 * 33], s[3 * 33]); o.z = pk2(s[4 * 33], s[5 * 33]); o.w = pk2(s[6 * 33], s[7 * 33]);
        const int dr = MODE ? win_destrow(n0 + n) : (n0 + n);
        *(GAS v4u*)(WT + (size_t)dr * K + k0 + 8 * c) = o; }
    LDS_WAIT(); asm volatile("" ::: "memory");
}
__device__ __forceinline__ void rope_entry(int pos, int j, float& c, float& s) {
    double inv = 1.0, p = 0.8659643233600653;
#pragma unroll
    for (int b = 0; b < 6; ++b) { if ((j >> b) & 1) inv *= p; p *= p; }
    const double rev = (double)pos * inv * 0.15915494309189535;
    const double fr = rev - __builtin_rint(rev);
    const double q = __builtin_rint(fr * 4.0); const double r = (fr - q * 0.25) * 6.283185307179586; const double r2 = r * r;
    double sn = -1.0 / 6227020800.0; sn = sn * r2 + 1.0 / 39916800.0; sn = sn * r2 - 1.0 / 362880.0; sn = sn * r2 + 1.0 / 5040.0; sn = sn * r2 - 1.0 / 120.0; sn = sn * r2 + 1.0 / 6.0; sn = r - r * r2 * sn;
    double cn = 1.0 / 87178291200.0; cn = cn * r2 - 1.0 / 479001600.0; cn = cn * r2 + 1.0 / 3628800.0; cn = cn * r2 - 1.0 / 40320.0; cn = cn * r2 + 1.0 / 720.0; cn = cn * r2 - 1.0 / 24.0; cn = cn * r2 + 0.5; cn = 1.0 - r2 * cn;
    const int qi = ((int)q) & 3;
    const double cc = qi == 0 ? cn : qi == 1 ? -sn : qi == 2 ? -cn : sn, ss = qi == 0 ? sn : qi == 1 ? cn : qi == 2 ? -sn : -cn;
    c = (float)cc; s = (float)ss;
}

__device__ __forceinline__ void ret_unit_naive(const bf16* Z, bf16* OC, int rowbase, int ntok, int cmask, int h, const float* S_in, float* S_out, float gC, float* sm, int tid) {
    const int dv = tid & 127, dq = tid >> 7, lane = tid & 63, wave = tid >> 6;
    float S[32];
#pragma unroll
    for (int kk = 0; kk < 32; ++kk) S[kk] = S_in ? S_in[(dq * 32 + kk) * 128 + dv] : 0.f;
    float* sq = sm; float* sk = sm + 1024; float* sv = sm + 2048; float* red = sm + 3072;
    for (int t0 = 0; t0 < ntok; t0 += 8) {
#pragma unroll
        for (int i = 0; i < 6; ++i) { const int e = tid + 512 * i, arr = e >> 10, rem = e & 1023, tt = rem >> 7, d = rem & 127;
            sm[e] = bf2f(Z[(size_t)(rowbase + t0 + tt) * BP + arr * 512 + h * 128 + d]); }
        __syncthreads();
#pragma unroll 1
        for (int tt = 0; tt < 8; ++tt) {
            const float vv = sv[tt * 128 + dv]; float a = 0.f;
#pragma unroll
            for (int kk = 0; kk < 32; ++kk) { S[kk] = fmaf(sk[tt * 128 + dq * 32 + kk], vv, S[kk]); a = fmaf(sq[tt * 128 + dq * 32 + kk], S[kk], a); }
            red[(tt * 4 + dq) * 128 + dv] = a;
            if (((t0 + tt) & cmask) == cmask) {
#pragma unroll
                for (int kk = 0; kk < 32; ++kk) S[kk] *= gC; }
        }
        __syncthreads();
        { const int tt = wave; const size_t row = (size_t)(rowbase + t0 + tt);
          float o0 = 0.f, o1 = 0.f;
#pragma unroll
          for (int q4 = 0; q4 < 4; ++q4) { o0 += red[(tt * 4 + q4) * 128 + lane]; o1 += red[(tt * 4 + q4) * 128 + lane + 64]; }
          const float ss = wave_sum(o0 * o0 + o1 * o1); const float rs = 1.0f / sqrtf(ss * (1.0f / 128.0f) + 1e-6f);
          const float g0 = bf2f(Z[row * BP + 1536 + h * 128 + lane]), g1 = bf2f(Z[row * BP + 1536 + h * 128 + lane + 64]);
          OC[row * BP + h * 128 + lane] = (bf16)f2bf(o0 * rs * g0); OC[row * BP + h * 128 + lane + 64] = (bf16)f2bf(o1 * rs * g1); }
        __syncthreads();
    }
#pragma unroll
    for (int kk = 0; kk < 32; ++kk) S_out[(dq * 32 + kk) * 128 + dv] = S[kk];
}
__device__ __forceinline__ void gm_unit_naive(const bf16* Z, bf16* OC, int rowbase, int ntok, int g, const float* w_s, const float* b_s, const float* ln_g, const float* ln_b, float* gvn_out, float* sm, int tid) {
    const int lane = tid & 63, wave = tid >> 6;
    for (int i = wave; i < ntok; i += 8) { const size_t row = (size_t)(rowbase + i);
        const float x0 = bf2f(Z[row * BP + 2560 + g * 128 + lane]), x1 = bf2f(Z[row * BP + 2560 + g * 128 + lane + 64]);
        const float mu = wave_sum(x0 + x1) * (1.0f / 128.0f); const float d0 = x0 - mu, d1 = x1 - mu;
        const float var = wave_sum(d0 * d0 + d1 * d1) * (1.0f / 128.0f); const float rs = 1.0f / sqrtf(var + 1e-5f);
        const float y0 = d0 * rs * ln_g[g * 128 + lane] + ln_b[g * 128 + lane], y1 = d1 * rs * ln_g[g * 128 + lane + 64] + ln_b[g * 128 + lane + 64];
        sm[i * 128 + lane] = y0; sm[i * 128 + lane + 64] = y1;
        if (gvn_out) { gvn_out[i * 512 + g * 128 + lane] = y0; gvn_out[i * 512 + g * 128 + lane + 64] = y1; } }
    __syncthreads();
    const int d = tid & 127, iq = tid >> 7;
    for (int i = iq; i < ntok; i += 4) { float a = b_s[g * 128 + i]; const float* wr = w_s + (size_t)(g * 128 + i) * 128;
        for (int j = 0; j <= i; ++j) a = fmaf(wr[j], sm[j * 128 + d], a);
        const size_t row = (size_t)(rowbase + i); const float uu = bf2f(Z[row * BP + 2048 + g * 128 + d]);
        OC[row * BP + 512 + g * 128 + d] = (bf16)f2bf(uu * a); }
    __syncthreads();
}

__device__ __forceinline__ void sample_unit(const bf16* Z, bf16* OC, int db, int h, const float* S_in, float* S_out, float* gvn_out, const float* w_s, const float* b_s, const float* ln_g, const float* ln_b, float* sm, int tid) {
    const int dv = tid & 127, dq = tid >> 7, lane = tid & 63, wave = tid >> 6; const size_t row0 = (size_t)MP + (size_t)db * 8;
    float S[32];
#pragma unroll
    for (int kk = 0; kk < 32; ++kk) S[kk] = S_in[(dq * 32 + kk) * 128 + dv];
    v4u pc = (v4u){0u, 0u, 0u, 0u};
    if (tid < 384) { const int arr = tid >> 7, rem = tid & 127, tt = rem >> 4, ch = rem & 15; pc = *(const v4u*)(Z + (row0 + tt) * BP + arr * 512 + h * 128 + ch * 8); }
    const bf16* zr = Z + (row0 + wave) * BP + h * 128;
    const float g0 = bf2f(zr[1536 + lane]), g1 = bf2f(zr[1536 + lane + 64]), x0 = bf2f(zr[2560 + lane]), x1 = bf2f(zr[2560 + lane + 64]);
    const float lg0 = ln_g[h * 128 + lane], lg1 = ln_g[h * 128 + lane + 64], lb0 = ln_b[h * 128 + lane], lb1 = ln_b[h * 128 + lane + 64];
    const int dd = tid & 127, iq = tid >> 7;
    const float u0 = bf2f(Z[(row0 + iq) * BP + 2048 + h * 128 + dd]), u1 = bf2f(Z[(row0 + iq + 4) * BP + 2048 + h * 128 + dd]);
    float* sq = sm; float* red = sm + 3072; float* vn = sm + 3072 + 4096;
    if (tid < 384) { float* dst = sm + tid * 8;
        dst[0] = __uint_as_float(pc.x << 16); dst[1] = __uint_as_float(pc.x & 0xffff0000u); dst[2] = __uint_as_float(pc.y << 16); dst[3] = __uint_as_float(pc.y & 0xffff0000u);
        dst[4] = __uint_as_float(pc.z << 16); dst[5] = __uint_as_float(pc.z & 0xffff0000u); dst[6] = __uint_as_float(pc.w << 16); dst[7] = __uint_as_float(pc.w & 0xffff0000u); }
    { const float mu = wave_sum(x0 + x1) * (1.0f / 128.0f); const float d0 = x0 - mu, d1 = x1 - mu;
      const float var = wave_sum(d0 * d0 + d1 * d1) * (1.0f / 128.0f); const float rs = 1.0f / sqrtf(var + 1e-5f);
      const float y0 = d0 * rs * lg0 + lb0, y1 = d1 * rs * lg1 + lb1;
      vn[wave * 128 + lane] = y0; vn[wave * 128 + lane + 64] = y1;
      gvn_out[wave * 512 + h * 128 + lane] = y0; gvn_out[wave * 512 + h * 128 + lane + 64] = y1; }
    __syncthreads();
    const float* sk = sm + 1024; const float* sv = sm + 2048;
#pragma unroll 1
    for (int tt = 0; tt < 8; ++tt) {
        const float vv = sv[tt * 128 + dv]; float a = 0.f;
#pragma unroll
        for (int kk = 0; kk < 32; ++kk) { S[kk] = fmaf(sk[tt * 128 + dq * 32 + kk], vv, S[kk]); a = fmaf(sq[tt * 128 + dq * 32 + kk], S[kk], a); }
        red[(tt * 4 + dq) * 128 + dv] = a;
    }
    { const float l2g = h == 0 ? -0.04580368961312479f : h == 1 ? -0.02272007650008353f : h == 2 ? -0.011315313227834146f : -0.005646563141142063f; const float gC = exp2f(8.0f * l2g);
#pragma unroll
      for (int kk = 0; kk < 32; ++kk) S_out[(dq * 32 + kk) * 128 + dv] = S[kk] * gC; }
    { float a0 = b_s[h * 128 + iq], a1 = b_s[h * 128 + iq + 4]; const float* w0 = w_s + (size_t)(h * 128 + iq) * 128; const float* w1 = w0 + 4 * 128;
#pragma unroll
      for (int j = 0; j < 8; ++j) { const float vj = vn[j * 128 + dd]; if (j <= iq) a0 = fmaf(w0[j], vj, a0); if (j <= iq + 4) a1 = fmaf(w1[j], vj, a1); }
      OC[(row0 + iq) * BP + 512 + h * 128 + dd] = (bf16)f2bf(u0 * a0); OC[(row0 + iq + 4) * BP + 512 + h * 128 + dd] = (bf16)f2bf(u1 * a1); }
    __syncthreads();
    { const int tt = wave; float o0 = 0.f, o1 = 0.f;
#pragma unroll
      for (int q4 = 0; q4 < 4; ++q4) { o0 += red[(tt * 4 + q4) * 128 + lane]; o1 += red[(tt * 4 + q4) * 128 + lane + 64]; }
      const float ss = wave_sum(o0 * o0 + o1 * o1); const float rs = 1.0f / sqrtf(ss * (1.0f / 128.0f) + 1e-6f);
      OC[(row0 + tt) * BP + h * 128 + lane] = (bf16)f2bf(o0 * rs * g0); OC[(row0 + tt) * BP + h * 128 + lane + 64] = (bf16)f2bf(o1 * rs * g1); }
    __syncthreads();
}

typedef short v4i16_t __attribute__((ext_vector_type(4)));
typedef unsigned u32x2_t __attribute__((ext_vector_type(2)));
#define MFMA16(a, b, c) __builtin_amdgcn_mfma_f32_16x16x32_bf16((a), (b), (c), 0, 0, 0)
__device__ __forceinline__ v4i16_t trrd(LAS unsigned char* p) { return __builtin_amdgcn_ds_read_tr16_b64_v4i16((LAS v4i16_t*)p); }
__device__ __forceinline__ bf16x8 cat4(v4i16_t a, v4i16_t b) { return (bf16x8){a[0], a[1], a[2], a[3], b[0], b[1], b[2], b[3]}; }
__device__ __forceinline__ unsigned pkb(float lo, float hi) { return pg8::pkbf(lo, hi); }
__device__ __forceinline__ bf16x8 pack8(f32x4 a, f32x4 b) { v4u w; w.x = pkb(a[0], a[1]); w.y = pkb(a[2], a[3]); w.z = pkb(b[0], b[1]); w.w = pkb(b[2], b[3]); return __builtin_bit_cast(bf16x8, w); }
__device__ __forceinline__ f32x4 unpk4(u32x2_t w) { return (f32x4){__uint_as_float(w.x << 16), __uint_as_float(w.x & 0xffff0000u), __uint_as_float(w.y << 16), __uint_as_float(w.y & 0xffff0000u)}; }

constexpr int R_RS = 272, R_RSV = 288, R_QS = 0, R_KS = 128 * R_RS, R_ST = 2 * 128 * R_RS, R_VS = 3 * 128 * R_RS;
static_assert(R_VS + 128 * R_RSV <= SCR_BYTES, "retention LDS");
constexpr int RS_K = 0, RS_VH = 128 * R_RS, RS_VST = 144;
__device__ __forceinline__ void ret_state_unit(const bf16* Z, bf16* SIMG, float* S_out, int b, int h, int half, LAS unsigned char* L, int tid) {
    const int lane = tid & 63, w = __builtin_amdgcn_readfirstlane(tid >> 6), c = lane & 15, g = lane >> 4, q = c >> 2, p = c & 3;
    const float l2g = h == 0 ? -0.04580368961312479f : h == 1 ? -0.02272007650008353f : h == 2 ? -0.011315313227834146f : -0.005646563141142063f;
    const float gC = exp2f(128.0f * l2g);
    f32x4 st[4];
#pragma unroll
    for (int i = 0; i < 4; ++i) st[i] = (f32x4){0.f, 0.f, 0.f, 0.f};
    const bf16* zb = Z + (size_t)b * SEQ * BP + h * 128;
    v4u rk[4], rv[2];
#pragma unroll
    for (int i = 0; i < 4; ++i) { const int idx = tid + 512 * i; rk[i] = *(const v4u*)(zb + (size_t)(idx >> 4) * BP + 512 + (idx & 15) * 8); }
#pragma unroll
    for (int i = 0; i < 2; ++i) { const int idx = tid + 512 * i; rv[i] = *(const v4u*)(zb + (size_t)(idx >> 3) * BP + 1024 + half * 64 + (idx & 7) * 8); }
#pragma unroll 1
    for (int n = 0; n < 16; ++n) {
#pragma unroll
        for (int i = 0; i < 4; ++i) { const int idx = tid + 512 * i; *(LAS v4u*)(L + RS_K + (idx >> 4) * R_RS + (idx & 15) * 16) = rk[i]; }
#pragma unroll
        for (int i = 0; i < 2; ++i) { const int idx = tid + 512 * i; *(LAS v4u*)(L + RS_VH + (idx >> 3) * RS_VST + (idx & 7) * 16) = rv[i]; }
        __syncthreads();
        if (n < 15) { const bf16* zn = zb + (size_t)(n + 1) * 128 * BP;
#pragma unroll
            for (int i = 0; i < 4; ++i) { const int idx = tid + 512 * i; rk[i] = *(const v4u*)(zn + (size_t)(idx >> 4) * BP + 512 + (idx & 15) * 8); }
#pragma unroll
            for (int i = 0; i < 2; ++i) { const int idx = tid + 512 * i; rv[i] = *(const v4u*)(zn + (size_t)(idx >> 3) * BP + 1024 + half * 64 + (idx & 7) * 8); } }
        { bf16x8 Ak[4];
#pragma unroll
          for (int s = 0; s < 4; ++s) Ak[s] = cat4(trrd(L + RS_K + (32 * s + 8 * g + q) * R_RS + (16 * w + 4 * p) * 2), trrd(L + RS_K + (32 * s + 8 * g + 4 + q) * R_RS + (16 * w + 4 * p) * 2));
#pragma unroll
          for (int dt = 0; dt < 4; ++dt) {
#pragma unroll
              for (int s = 0; s < 4; ++s) { const bf16x8 Bv = cat4(trrd(L + RS_VH + (32 * s + 8 * g + q) * RS_VST + (16 * dt + 4 * p) * 2), trrd(L + RS_VH + (32 * s + 8 * g + 4 + q) * RS_VST + (16 * dt + 4 * p) * 2));
                  st[dt] = MFMA16(Ak[s], Bv, st[dt]); }
              st[dt] = st[dt] * gC; } }
        if (n < 15) { bf16* img = SIMG + ((size_t)((b * 4 + h) * 16 + n + 1)) * 16384 + (size_t)(64 * half + c) * 128 + 16 * w + 4 * g;
#pragma unroll
            for (int dt = 0; dt < 4; ++dt) { u32x2_t wv; wv.x = pkb(st[dt][0], st[dt][1]); wv.y = pkb(st[dt][2], st[dt][3]); *(u32x2_t*)(img + (size_t)(16 * dt) * 128) = wv; } }
        __syncthreads();
    }
#pragma unroll
    for (int dt = 0; dt < 4; ++dt)
#pragma unroll
        for (int e = 0; e < 4; ++e) S_out[(16 * w + 4 * g + e) * 128 + 64 * half + 16 * dt + c] = st[dt][e];
}
__device__ __forceinline__ void ret_out_phase(const bf16* Z, bf16* OC, const bf16* SIMG, int b0, int nb, int rk, int nl, LAS unsigned char* L, int tid) {
    const int lane = tid & 63, w = __builtin_amdgcn_readfirstlane(tid >> 6), c = lane & 15, g = lane >> 4, q = c >> 2, p = c & 3;
    const int total = 64 * nb; if (rk >= total) return;
    v4u pq[4], pk[4], pv[4], ps[4];
#define RO_LOAD(u_) do { const int b_ = b0 + ((u_) >> 6), n_ = ((u_) >> 2) & 15, h_ = (u_) & 3; const size_t r_ = (size_t)b_ * SEQ + (size_t)n_ * 128; const bf16* sg_ = SIMG + ((size_t)((b_ * 4 + h_) * 16 + n_)) * 16384; \
        _Pragma("unroll") for (int i = 0; i < 4; ++i) { const int idx = tid + 512 * i, row = idx >> 4, ch = idx & 15; const bf16* src = Z + (r_ + row) * BP + h_ * 128 + ch * 8; \
            pq[i] = *(const v4u*)src; pk[i] = *(const v4u*)(src + 512); pv[i] = *(const v4u*)(src + 1024); ps[i] = *(const v4u*)(sg_ + row * 128 + ch * 8); } } while (0)
    RO_LOAD(rk);
#pragma unroll 1
    for (int uid = rk; uid < total; uid += nl) {
    const int b = b0 + (uid >> 6), n = (uid >> 2) & 15, h = uid & 3;
    const size_t r0 = (size_t)b * SEQ + (size_t)n * 128;
#pragma unroll
    for (int i = 0; i < 4; ++i) { const int idx = tid + 512 * i, row = idx >> 4, ch = idx & 15;
        *(LAS v4u*)(L + R_QS + row * R_RS + ch * 16) = pq[i]; *(LAS v4u*)(L + R_KS + row * R_RS + ch * 16) = pk[i]; *(LAS v4u*)(L + R_VS + row * R_RSV + ch * 16) = pv[i]; *(LAS v4u*)(L + R_ST + row * R_RS + ch * 16) = ps[i]; }
    __syncthreads();
    { const int un = uid + nl < total ? uid + nl : uid; RO_LOAD(un); }
    u32x2_t gv8[8];
    { const bf16* gp0 = Z + (r0 + 16 * w + c) * BP + 1536 + h * 128 + 4 * g;
#pragma unroll
      for (int dt = 0; dt < 8; ++dt) gv8[dt] = *(const u32x2_t*)(gp0 + 16 * dt); }
    bf16x8 Bq[4];
#pragma unroll
    for (int s = 0; s < 4; ++s) Bq[s] = *(const LAS bf16x8*)(L + R_QS + (16 * w + c) * R_RS + (32 * s + 8 * g) * 2);
    f32x4 pt[8];
#pragma unroll
    for (int jt = 0; jt < 8; ++jt) { f32x4 a = (f32x4){0.f, 0.f, 0.f, 0.f};
        if (jt <= w) {
#pragma unroll
            for (int s = 0; s < 4; ++s) { const bf16x8 A = *(const LAS bf16x8*)(L + R_KS + (16 * jt + c) * R_RS + (32 * s + 8 * g) * 2); a = MFMA16(A, Bq[s], a); }
            if (jt == w) {
#pragma unroll
                for (int e = 0; e < 4; ++e) if (4 * g + e > c) a[e] = 0.f; }
        }
        pt[jt] = a; }
    bf16x8 bfr[4];
#pragma unroll
    for (int s = 0; s < 4; ++s) bfr[s] = pack8(pt[2 * s], pt[2 * s + 1]);
    f32x4 ot[8];
#pragma unroll
    for (int dt = 0; dt < 8; ++dt) { f32x4 a = (f32x4){0.f, 0.f, 0.f, 0.f};
        if (n > 0) {
#pragma unroll
            for (int s = 0; s < 4; ++s) { const bf16x8 A = *(const LAS bf16x8*)(L + R_ST + (16 * dt + c) * R_RS + (32 * s + 8 * g) * 2); a = MFMA16(A, Bq[s], a); } }
#pragma unroll
        for (int s = 0; s < 4; ++s) if (2 * s <= w) {
            const v4i16_t a0 = trrd(L + R_VS + (32 * s + 4 * g + q) * R_RSV + (16 * dt + 4 * p) * 2), a1 = trrd(L + R_VS + (32 * s + 16 + 4 * g + q) * R_RSV + (16 * dt + 4 * p) * 2);
            a = MFMA16(cat4(a0, a1), bfr[s], a); }
        ot[dt] = a; }
    { float ss = 0.f;
#pragma unroll
      for (int dt = 0; dt < 8; ++dt) ss += (ot[dt][0] * ot[dt][0] + ot[dt][1] * ot[dt][1]) + (ot[dt][2] * ot[dt][2] + ot[dt][3] * ot[dt][3]);
      ss += __shfl_xor(ss, 16); ss += __shfl_xor(ss, 32);
      const float rs = 1.0f / sqrtf(ss * (1.0f / 128.0f) + 1e-6f);
      const size_t row = r0 + 16 * w + c; bf16* op = OC + row * BP + h * 128 + 4 * g;
#pragma unroll
      for (int dt = 0; dt < 8; ++dt) { const f32x4 gg = unpk4(gv8[dt]); const f32x4 o = ot[dt] * rs * gg;
          u32x2_t wv; wv.x = pkb(o[0], o[1]); wv.y = pkb(o[2], o[3]); *(u32x2_t*)(op + 16 * dt) = wv; } }
    __syncthreads();
    }
#undef RO_LOAD
}
__device__ __forceinline__ void gm_unit_mfma(const bf16* Z, bf16* OC, const bf16* Wb, const float* b_s, const float* ln_g, const float* ln_b, size_t r0, int g, LAS unsigned char* L, int tid) {
    const int lane = tid & 63, w = __builtin_amdgcn_readfirstlane(tid >> 6), c = lane & 15, g4 = lane >> 4, q = c >> 2, p = c & 3;
    u32x2_t uv[8];
    { const bf16* up0 = Z + (r0 + 16 * w + c) * BP + 2048 + g * 128 + 4 * g4;
#pragma unroll
      for (int dt = 0; dt < 8; ++dt) uv[dt] = *(const u32x2_t*)(up0 + 16 * dt); }
    {
      const bf16* zb = Z + r0 * BP + 2560 + g * 128;
      v4u pv[4];
#pragma unroll
      for (int i = 0; i < 4; ++i) { const int idx = tid + 512 * i; pv[i] = *(const v4u*)(zb + (size_t)(idx >> 4) * BP + (idx & 15) * 8); }
      const int ch = tid & 15;
      const f32x4 lg0 = *(const f32x4*)(ln_g + g * 128 + ch * 8), lg1 = *(const f32x4*)(ln_g + g * 128 + ch * 8 + 4), lb0 = *(const f32x4*)(ln_b + g * 128 + ch * 8), lb1 = *(const f32x4*)(ln_b + g * 128 + ch * 8 + 4);
#pragma unroll
      for (int i = 0; i < 4; ++i) { const int row = (tid + 512 * i) >> 4;
          u32x2_t lo2, hi2; lo2.x = pv[i].x; lo2.y = pv[i].y; hi2.x = pv[i].z; hi2.y = pv[i].w;
          const f32x4 x0 = unpk4(lo2), x1 = unpk4(hi2);
          float s = (x0[0] + x0[1]) + (x0[2] + x0[3]) + (x1[0] + x1[1]) + (x1[2] + x1[3]);
          s += __shfl_xor(s, 1); s += __shfl_xor(s, 2); s += __shfl_xor(s, 4); s += __shfl_xor(s, 8);
          const float mu = s * (1.0f / 128.0f); const f32x4 d0 = x0 - mu, d1 = x1 - mu;
          float v = (d0[0] * d0[0] + d0[1] * d0[1]) + (d0[2] * d0[2] + d0[3] * d0[3]) + (d1[0] * d1[0] + d1[1] * d1[1]) + (d1[2] * d1[2] + d1[3] * d1[3]);
          v += __shfl_xor(v, 1); v += __shfl_xor(v, 2); v += __shfl_xor(v, 4); v += __shfl_xor(v, 8);
          const float rs = 1.0f / sqrtf(v * (1.0f / 128.0f) + 1e-5f);
          const f32x4 y0 = d0 * rs * lg0 + lb0, y1 = d1 * rs * lg1 + lb1;
          v4u wv; wv.x = pkb(y0[0], y0[1]); wv.y = pkb(y0[2], y0[3]); wv.z = pkb(y1[0], y1[1]); wv.w = pkb(y1[2], y1[3]);
          *(LAS v4u*)(L + row * R_RSV + ch * 16) = wv; } }
    __syncthreads();
    f32x4 mt[8];
#pragma unroll
    for (int i = 0; i < 8; ++i) mt[i] = (f32x4){0.f, 0.f, 0.f, 0.f};
    bf16x8 Bw4[4];
#pragma unroll
    for (int s = 0; s < 4; ++s) Bw4[s] = *(const bf16x8*)(Wb + (size_t)(g * 128 + 16 * w + c) * 128 + 32 * s + 8 * g4);
#pragma unroll
    for (int s = 0; s < 4; ++s) if (2 * s <= w) {
        const bf16x8 Bw = Bw4[s];
#pragma unroll
        for (int dt = 0; dt < 8; ++dt) { const bf16x8 A = cat4(trrd(L + (32 * s + 8 * g4 + q) * R_RSV + (16 * dt + 4 * p) * 2), trrd(L + (32 * s + 8 * g4 + 4 + q) * R_RSV + (16 * dt + 4 * p) * 2)); mt[dt] = MFMA16(A, Bw, mt[dt]); } }
    { const size_t row = r0 + 16 * w + c; const float bias = b_s[g * 128 + 16 * w + c]; bf16* op = OC + row * BP + 512 + g * 128 + 4 * g4;
#pragma unroll
      for (int dt = 0; dt < 8; ++dt) { const f32x4 uu = unpk4(uv[dt]); const f32x4 o = uu * (mt[dt] + bias);
          u32x2_t wv; wv.x = pkb(o[0], o[1]); wv.y = pkb(o[2], o[3]); *(u32x2_t*)(op + 16 * dt) = wv; } }
    __syncthreads();
}
constexpr int A_KST = 144, A_K = 0, A_V = 256 * A_KST;
template <bool FAST>
__device__ __forceinline__ void attn_tile_mfma(const bf16x8 Bq0, const bf16x8 Bq1, bf16* orow, int irel, float sink2, int sg0, int jmin, int odd, LAS unsigned char* L, int lane) {
    const int c = lane & 15, g = lane >> 4, q = c >> 2, p = c & 3;
    bf16x8 Bq[2]; Bq[0] = Bq0; Bq[1] = Bq1;
    f32x4 pt[10]; float m = sink2;
#pragma unroll
    for (int t = 0; t < 10; ++t) { const int kt = 2 * sg0 + t; f32x4 a = (f32x4){0.f, 0.f, 0.f, 0.f};
        const bool dead = FAST && (t < odd || t > 8 + odd);
        if (!dead) {
#pragma unroll
            for (int s = 0; s < 2; ++s) { const bf16x8 A = *(const LAS bf16x8*)(L + A_K + (16 * kt + c) * A_KST + (32 * s + 8 * g) * 2); a = MFMA16(A, Bq[s], a); }
            if (FAST) {
                if (t == odd) {
#pragma unroll
                    for (int e = 0; e < 4; ++e) if (4 * g + e < c) a[e] = -INFINITY; }
                else if (t == 8 + odd) {
#pragma unroll
                    for (int e = 0; e < 4; ++e) if (4 * g + e > c) a[e] = -INFINITY; }
            } else {
#pragma unroll
                for (int e = 0; e < 4; ++e) { const int j = 16 * kt + 4 * g + e; if (j < irel || j > irel + 128 || j < jmin) a[e] = -INFINITY; }
            }
            m = fmaxf(fmaxf(m, fmaxf(a[0], a[1])), fmaxf(a[2], a[3]));
        } else a = (f32x4){-INFINITY, -INFINITY, -INFINITY, -INFINITY};
        pt[t] = a; }
    m = fmaxf(m, __shfl_xor(m, 16)); m = fmaxf(m, __shfl_xor(m, 32));
    float l = 0.f;
#pragma unroll
    for (int t = 0; t < 10; ++t)
#pragma unroll
        for (int e = 0; e < 4; ++e) { const float pe = __builtin_amdgcn_exp2f(pt[t][e] - m); pt[t][e] = pe; l += pe; }
    l += __shfl_xor(l, 16); l += __shfl_xor(l, 32); l += __builtin_amdgcn_exp2f(sink2 - m);
    f32x4 ot[4];
#pragma unroll
    for (int dt = 0; dt < 4; ++dt) ot[dt] = (f32x4){0.f, 0.f, 0.f, 0.f};
#pragma unroll
    for (int s = 0; s < 5; ++s) { const bf16x8 bf = pack8(pt[2 * s], pt[2 * s + 1]); const int R0 = 32 * (sg0 + s) + 4 * g + q;
#pragma unroll
        for (int dt = 0; dt < 4; ++dt) { const v4i16_t a0 = trrd(L + A_V + R0 * A_KST + (16 * dt + 4 * p) * 2), a1 = trrd(L + A_V + (R0 + 16) * A_KST + (16 * dt + 4 * p) * 2); ot[dt] = MFMA16(cat4(a0, a1), bf, ot[dt]); } }
    const float inv = 1.0f / l;
#pragma unroll
    for (int dt = 0; dt < 4; ++dt) { const f32x4 o = ot[dt] * inv; u32x2_t wv; wv.x = pkb(o[0], o[1]); wv.y = pkb(o[2], o[3]); *(u32x2_t*)(orow + 16 * dt + 4 * g) = wv; }
}
constexpr int SG_BK = 256, SG_RS = SG_BK * 2, SG_OP = 64 * SG_RS, SG_BUF = 2 * SG_OP;
static_assert(2 * SG_BUF <= SCR_BYTES, "sample GEMM LDS");
template <class Epi> __device__ __forceinline__ void sgemm_phase(LAS unsigned char* L, const bf16* A, const bf16* Bt, int N, int K, const Epi& E, int lda, int tm0, int ntm, int vid, int nv, int it0, int it1, int tid_in) {
    int tid = tid_in; asm volatile("" : "+v"(tid));
    const int lane = tid & 63, w = __builtin_amdgcn_readfirstlane(tid >> 6), c = lane & 15, g = lane >> 4, srow = tid >> 5, sch = tid & 31, tq = w & 3, nh = w >> 2;
    const int nk = K / SG_BK, total = ntm * (N / 64);
    const unsigned a_row = (unsigned)((16 * tq + c) * SG_RS), w_row0 = (unsigned)(SG_OP + (32 * nh + 8 * (c >> 2) + (c & 3)) * SG_RS), w_row1 = w_row0 + 4 * SG_RS;
    unsigned st_a[4], st_b[4];
#pragma unroll
    for (int i = 0; i < 4; ++i) { const int r = srow + 16 * i; st_a[i] = (unsigned)(r * SG_RS + 16 * (sch ^ (r & 15))); st_b[i] = (unsigned)(SG_OP + r * SG_RS + 16 * (sch ^ (4 * ((r >> 3) & 3) + (r & 3)))); }
    int nun = 0; { const int first = vid + it0 * nv; if (first < total && it1 > it0) { nun = (total - 1 - first) / nv + 1; if (nun > it1 - it0) nun = it1 - it0; } }
    if (nun <= 0) return;
    const int lnk = nk == 4 ? 2 : 4, S = nun * nk;
    f32x4 acc0 = (f32x4){0.f, 0.f, 0.f, 0.f}, acc1 = acc0;
    v4u xa[4], xb[4], ya[4], yb[4];
#define SG_LOAD(RA, RB, s_) do { const int sc_ = (s_) < S ? (s_) : S - 1, j_ = sc_ >> lnk, kt_ = sc_ - (j_ << lnk), ux_ = vid + (it0 + j_) * nv, tn_ = ux_ / ntm, tm_ = tm0 + ux_ % ntm; \
        const bf16* ga = A + (size_t)(64 * tm_ + srow) * lda + sch * 8 + kt_ * SG_BK; const bf16* gb = Bt + (size_t)(64 * tn_ + srow) * K + sch * 8 + kt_ * SG_BK; \
        _Pragma("unroll") for (int i = 0; i < 4; ++i) { RA[i] = *(const v4u*)(ga + (size_t)(16 * i) * lda); RB[i] = *(const v4u*)(gb + (size_t)(16 * i) * K); } } while (0)
#define SG_STORE(RA, RB, off) do { _Pragma("unroll") for (int i = 0; i < 4; ++i) { *(LAS v4u*)(L + (off) + st_a[i]) = RA[i]; *(LAS v4u*)(L + (off) + st_b[i]) = RB[i]; } } while (0)
#define SG_COMPUTE(off) do { _Pragma("unroll") for (int ks = 0; ks < SG_BK / 32; ++ks) { const unsigned po = 16u * (unsigned)((4 * ks + g) ^ c); \
            const bf16x8 T = *(const LAS bf16x8*)(L + (off) + a_row + po), W0 = *(const LAS bf16x8*)(L + (off) + w_row0 + po), W1 = *(const LAS bf16x8*)(L + (off) + w_row1 + po); \
            acc0 = MFMA16(W0, T, acc0); acc1 = MFMA16(W1, T, acc1); } } while (0)
    SG_LOAD(ya, yb, 0); SG_STORE(ya, yb, 0);
    SG_LOAD(xa, xb, 1);
    __syncthreads();
#pragma unroll 1
    for (int s = 0; s < S; s += 2) {
        SG_LOAD(ya, yb, s + 2);
        if ((s & (nk - 1)) == 0) { acc0 = (f32x4){0.f, 0.f, 0.f, 0.f}; acc1 = acc0; }
        SG_COMPUTE(0);
        SG_STORE(xa, xb, SG_BUF);
        __syncthreads();
        SG_LOAD(xa, xb, s + 3);
        SG_COMPUTE(SG_BUF);
        if (((s + 1) & (nk - 1)) == nk - 1) {
            const int j = (s + 1) >> lnk, uidx = vid + (it0 + j) * nv, tn = uidx / ntm, tm = tm0 + uidx % ntm;
            const int r = MP + 64 * tm + 16 * tq + c, col = 64 * tn + 32 * nh + 8 * g;
            float ss = E.apply(r, col, acc0, acc1, E.rowpre(r));
            if (Epi::HAS_POST) { ss += __shfl_xor(ss, 16); ss += __shfl_xor(ss, 32); E.post(r, ss, g == 0); } }
        SG_STORE(ya, yb, 0);
        __syncthreads();
    }
#undef SG_LOAD
#undef SG_STORE
#undef SG_COMPUTE
}
constexpr int S8_BK = 128, S8_RS = S8_BK * 2, S8_OP = 128 * S8_RS, S8_BUF = 2 * S8_OP;
static_assert(2 * S8_BUF <= SCR_BYTES, "128x128 sample GEMM LDS");
template <class Epi> __device__ __forceinline__ void sgemm128_phase(LAS unsigned char* L, const bf16* A, const bf16* Bt, int N, int K, const Epi& E, int lda, int tm0, int vid, int nv, int it0, int it1, int tid_in) {
    int tid = tid_in; asm volatile("" : "+v"(tid));
    const int lane = tid & 63, w = __builtin_amdgcn_readfirstlane(tid >> 6), c = lane & 15, g = lane >> 4, srow = tid >> 4, sch = tid & 15, tq = w & 3, nh = w >> 2;
    const int nk = K / S8_BK, total = N / 128;
    const unsigned a_row = (unsigned)((32 * tq + c) * S8_RS), w_row = (unsigned)(S8_OP + (64 * nh + 8 * (c >> 2) + (c & 3)) * S8_RS);
    unsigned st_a[4], st_b[4];
#pragma unroll
    for (int i = 0; i < 4; ++i) { const int r = srow + 32 * i; st_a[i] = (unsigned)(r * S8_RS + 16 * (sch ^ (r & 15))); st_b[i] = (unsigned)(S8_OP + r * S8_RS + 16 * (sch ^ (4 * ((r >> 3) & 3) + (r & 3)))); }
    for (int it = it0; it < it1; ++it) {
        const int tn = vid + it * nv; if (tn >= total) break;
        const bf16* ga = A + (size_t)(64 * tm0 + srow) * lda + sch * 8; const bf16* gb = Bt + (size_t)(128 * tn + srow) * K + sch * 8;
        f32x4 acc[2][2][2];
#pragma unroll
        for (int i = 0; i < 8; ++i) acc[i >> 2][(i >> 1) & 1][i & 1] = (f32x4){0.f, 0.f, 0.f, 0.f};
        v4u xa[4], xb[4], ya[4], yb[4];
#define S8_LOAD(RA, RB, kk) do { _Pragma("unroll") for (int i = 0; i < 4; ++i) { RA[i] = *(const v4u*)(ga + (size_t)(32 * i) * lda + (kk) * S8_BK); RB[i] = *(const v4u*)(gb + (size_t)(32 * i) * K + (kk) * S8_BK); } } while (0)
#define S8_STORE(RA, RB, off) do { _Pragma("unroll") for (int i = 0; i < 4; ++i) { *(LAS v4u*)(L + (off) + st_a[i]) = RA[i]; *(LAS v4u*)(L + (off) + st_b[i]) = RB[i]; } } while (0)
#define S8_COMPUTE(off) do { _Pragma("unroll") for (int ks = 0; ks < S8_BK / 32; ++ks) { const unsigned po = 16u * (unsigned)((4 * ks + g) ^ c); \
            const bf16x8 T0 = *(const LAS bf16x8*)(L + (off) + a_row + po), T1 = *(const LAS bf16x8*)(L + (off) + a_row + 16 * S8_RS + po); \
            _Pragma("unroll") for (int t = 0; t < 4; ++t) { const bf16x8 W = *(const LAS bf16x8*)(L + (off) + w_row + (32 * (t >> 1) + 4 * (t & 1)) * S8_RS + po); \
                acc[0][t >> 1][t & 1] = MFMA16(W, T0, acc[0][t >> 1][t & 1]); acc[1][t >> 1][t & 1] = MFMA16(W, T1, acc[1][t >> 1][t & 1]); } } } while (0)
        S8_LOAD(ya, yb, 0); S8_STORE(ya, yb, 0);
        S8_LOAD(xa, xb, 1);
        __syncthreads();
#pragma unroll 1
        for (int kt = 0; kt < nk; kt += 2) {
            S8_LOAD(ya, yb, kt + 2 < nk ? kt + 2 : nk - 1);
            S8_COMPUTE(0);
            S8_STORE(xa, xb, S8_BUF);
            __syncthreads();
            S8_LOAD(xa, xb, kt + 3 < nk ? kt + 3 : nk - 1);
            S8_COMPUTE(S8_BUF);
            if (kt + 2 < nk) S8_STORE(ya, yb, 0);
            __syncthreads();
        }
#undef S8_LOAD
#undef S8_STORE
#undef S8_COMPUTE
#pragma unroll
        for (int ti = 0; ti < 2; ++ti) { const int r = MP + 64 * tm0 + 32 * tq + 16 * ti + c; const float pre = E.rowpre(r); float ss = 0.f;
#pragma unroll
            for (int pq = 0; pq < 2; ++pq) ss += E.apply(r, 128 * tn + 64 * nh + 32 * pq + 8 * g, acc[ti][pq][0], acc[ti][pq][1], pre);
            if (Epi::HAS_POST) { ss += __shfl_xor(ss, 16); ss += __shfl_xor(ss, 32); E.post(r, ss, g == 0); } }
    }
}

template <class Epi, int TM, int TN> __device__ __forceinline__ void sg3_phase(LAS unsigned char* L, const bf16* A, const bf16* Bt, int N, int K, const Epi& E, int lda, int tm0, int ntm, int vid, int nv, int it0, int it1, int tid_in) {
    static_assert((TM == 128 && TN == 128) || (TM == 64 && TN == 64), "tile");
    constexpr int ABYTES = TM * 128, SLOT = ABYTES + TN * 128, NS = TM == 128 ? 4 : 8, NI = TM / 64, P = 2 * NI, MT = TM / 64, NT = TN / 32;
    static_assert(NS * SLOT <= SCR_BYTES, "sample GEMM ring");
    int tid = tid_in; asm volatile("" : "+v"(tid));
    const int lane = tid & 63, w = __builtin_amdgcn_readfirstlane(tid >> 6), c = lane & 15, g = lane >> 4, wr = w >> 1, wc = w & 1;
    const int sb_ = lane * 16, swz = sb_ ^ (((sb_ >> 9) & 1) << 5), rr = swz >> 6, cc = (swz & 63) >> 1;
    const unsigned voA = (unsigned)(((w >> 1) * 16 + rr) * lda + (w & 1) * 32 + cc) * 2u;
    const unsigned voB = (unsigned)(((w >> 2) * 32 + pg8::perm32(16 * ((w >> 1) & 1) + rr)) * K + (w & 1) * 32 + cc) * 2u;
    const unsigned aoff = (unsigned)pg8::lds_byte((TM == 128 ? 32 : 16) * wr + c, 8 * g), boff = (unsigned)(ABYTES + pg8::lds_byte((TN / 2) * wc + c, 8 * g));
    const int nk = K >> 6, total = TM == 128 ? N / 128 : ntm * (N / 64);
#define SG3_WAIT(n) asm volatile("s_waitcnt vmcnt(%0)" :: "n"(n) : "memory")
    for (int it = it0; it < it1; ++it) {
        const int u = vid + it * nv; if (u >= total) break;
        const int tn = TM == 128 ? u : u / ntm, tm = TM == 128 ? tm0 : tm0 + u % ntm;
        const char* pa = (const char*)(A + (size_t)(64 * tm) * lda); const char* pb = (const char*)(Bt + (size_t)(TN * tn) * K);
        const int rbase = MP + 64 * tm + (TM == 128 ? 32 : 16) * wr + c;
        float pre[MT];
#pragma unroll
        for (int m = 0; m < MT; ++m) pre[m] = E.rowpre(rbase + 16 * m);
        f32x4 acc[MT][NT];
#pragma unroll
        for (int m = 0; m < MT; ++m)
#pragma unroll
            for (int n = 0; n < NT; ++n) acc[m][n] = (f32x4){0.f, 0.f, 0.f, 0.f};
#define SG3_ISSUE(kk, slot) do { const char* qa_ = pa + (size_t)(kk) * 128; const char* qb_ = pb + (size_t)(kk) * 128; LAS unsigned char* ld_ = L + (slot) * SLOT + w * 1024; \
        _Pragma("unroll") for (int i_ = 0; i_ < NI; ++i_) { \
            __builtin_amdgcn_global_load_lds((const unsigned*)(qa_ + (size_t)i_ * 128 * lda + voA), (LAS unsigned*)(ld_ + i_ * 8192), 16, 0, 0); \
            __builtin_amdgcn_global_load_lds((const unsigned*)(qb_ + (size_t)i_ * 128 * K + voB), (LAS unsigned*)(ld_ + ABYTES + i_ * 8192), 16, 0, 0); } } while (0)
#pragma unroll
        for (int s0 = 0; s0 < NS - 1; ++s0) SG3_ISSUE(s0, s0);
        int slot = 0, nslot = NS - 1;
#define SG3_BAR() do { __builtin_amdgcn_s_barrier(); asm volatile("" ::: "memory"); __builtin_amdgcn_sched_barrier(0); } while (0)
#define SG3_COMPUTE() do { const unsigned so = (unsigned)(slot * SLOT); bf16x8 T[MT][2], W[NT][2]; \
            _Pragma("unroll") for (int m = 0; m < MT; ++m) _Pragma("unroll") for (int kk = 0; kk < 2; ++kk) T[m][kk] = *(const LAS bf16x8*)(L + so + aoff + m * 2048 + kk * 1024); \
            _Pragma("unroll") for (int n = 0; n < NT; ++n) _Pragma("unroll") for (int kk = 0; kk < 2; ++kk) W[n][kk] = *(const LAS bf16x8*)(L + so + boff + n * 2048 + kk * 1024); \
            _Pragma("unroll") for (int kk = 0; kk < 2; ++kk) _Pragma("unroll") for (int m = 0; m < MT; ++m) _Pragma("unroll") for (int n = 0; n < NT; ++n) acc[m][n] = MFMA16(W[n][kk], T[m][kk], acc[m][n]); \
            slot = slot + 1 == NS ? 0 : slot + 1; } while (0)
#pragma unroll 1
        for (int k = 0; k + NS - 1 < nk; ++k) {
            SG3_WAIT((NS - 2) * P); SG3_BAR();
            SG3_ISSUE(k + NS - 1, nslot); nslot = nslot + 1 == NS ? 0 : nslot + 1;
            SG3_COMPUTE();
        }
#define SG3_TAIL(j) if constexpr (NS - 2 >= (j)) { SG3_WAIT((j) * P); SG3_BAR(); SG3_COMPUTE(); }
        SG3_TAIL(6) SG3_TAIL(5) SG3_TAIL(4) SG3_TAIL(3) SG3_TAIL(2) SG3_TAIL(1) SG3_TAIL(0)
#undef SG3_TAIL
#undef SG3_COMPUTE
#undef SG3_ISSUE
        asm volatile("s_waitcnt lgkmcnt(0)" ::: "memory"); SG3_BAR();
#undef SG3_BAR
#pragma unroll
        for (int m = 0; m < MT; ++m) { const int r = rbase + 16 * m; float ss = 0.f;
#pragma unroll
            for (int pq = 0; pq < NT / 2; ++pq) ss += E.apply(r, TN * tn + (TN / 2) * wc + 32 * pq + 8 * g, acc[m][2 * pq], acc[m][2 * pq + 1], pre[m]);
            if (Epi::HAS_POST) { ss += __shfl_xor(ss, 16); ss += __shfl_xor(ss, 32); E.post(r, ss, g == 0); } }
    }
#undef SG3_WAIT
    __syncthreads();
}

#ifndef NSUB
#define NSUB 1u
#endif
#ifndef SG3_MINN
#define SG3_MINN 4096
#endif
#ifndef SG3_WIDE
#define SG3_WIDE 1
#endif
#ifndef FINE128
#define FINE128 1
#endif
#ifndef FUSE_FIN
#define FUSE_FIN 1
#endif
#ifndef STAGGER
#define STAGGER 1
#endif
#ifndef SKEW_TICKS
#define SKEW_TICKS 0
#endif
struct Args { const float* in[21]; float* out; unsigned char* ws; };
__global__ void __launch_bounds__(NWAVES * 64, 2) fwd_kernel(Args args) {
    extern __shared__ __attribute__((aligned(16))) unsigned char lds[];
    LAS unsigned char* const L = (LAS unsigned char*)lds;
    volatile LAS unsigned* const MISC = (volatile LAS unsigned*)(L + MISC_OFF);
    const int G = gridDim.x, bx = blockIdx.x, vcu = (G % 8 == 0) ? (bx % 8) * (G / 8) + bx / 8 : bx;
    unsigned char* const ws = args.ws; float* const out = args.out;
    gu32* const ctl = (gu32*)(ws + WS_CTL);
    for (int u = threadIdx.x; u < (LDS_BYTES - LDSCTL_OFF) / 4; u += NWAVES * 64) ((LAS unsigned*)(L + LDSCTL_OFF))[u] = 0u;
    __syncthreads();
    const XcdBarrier bar = xcd_barrier_post((unsigned*)(ctl + CW_BAR), MISC + 8);
    float* const sm = (float*)lds;
    int tid_k = threadIdx.x;
#define INP(i) (args.in[i])
#define WSP(T, off) ((T*)(ws + (off)))
#define ROWSS(k) (WSP(float, WS_ROWSS) + (size_t)(k) * M)
#define ROPEC WSP(float, WS_ROPE)
#define ROPES (WSP(float, WS_ROPE) + ROPE_ROWS * 64)
#define TID_LOAD() int tid = tid_k; asm volatile("" : "+v"(tid)); const int lane = tid & 63, wave = __builtin_amdgcn_readfirstlane(tid >> 6); (void)lane; (void)wave
#define GRP_LOAD() const volatile LAS unsigned* const MISCv = (const volatile LAS unsigned*)MISC; const int nl = __builtin_amdgcn_readfirstlane((int)MISCv[12]), ng = __builtin_amdgcn_readfirstlane((int)MISCv[13]), rk = __builtin_amdgcn_readfirstlane((int)MISCv[14]), gi = __builtin_amdgcn_readfirstlane((int)MISCv[15]); \
    const int b0 = gi * NBATCH / ng, b1 = (gi + 1) * NBATCH / ng, t0 = gi * 16 / ng, t1 = (gi + 1) * 16 / ng, d0 = 8 * t0, d1 = 8 * t1; (void)b1; (void)d1; (void)d0; (void)t1; (void)rk; (void)nl
#define LBAR() group_barrier((unsigned*)(ctl + CW_BAR), MISC + 12, tid_k)
#define GEMM_PHASE(EPI, EINIT, Aptr, LDA, Bptr, NN, KK) GEMM_PHASE_H(EPI, EINIT, Aptr, LDA, Bptr, NN, KK, 0, 2, true)
#define GEMM_PHASE_H(EPI, EINIT, Aptr, LDA, Bptr, NN, KK, HH, NH, WHOLE) do { GRP_LOAD(); \
        const int nbw = b1 - b0, hb0 = (WHOLE) ? 0 : (HH) * nbw / (NH), hnb = (WHOLE) ? nbw : ((HH) + 1) * nbw / (NH) - hb0; const bool fine = (WHOLE) || (HH) == 0; \
        pg8::Gemm g{Aptr, Bptr, MP, NN, KK, LDA}; pg8::GroupOrder S{8 * (b0 + hb0), 8 * hnb, (NN) / 256, nl, rk}; pg8::EPI E EINIT; \
        const int nrem = (8 * hnb * ((NN) / 256)) % nl, lo = (nrem && nl > nrem) ? nrem : 0; \
        const bool wide = SG3_WIDE && (NN) >= SG3_MINN && (t1 - t0) == 2;     \
        const int nfine = wide ? ((NN) / 128 + (nl - lo) - 1) / (nl - lo) : ((t1 - t0) * ((NN) / 64) + (nl - lo) - 1) / (nl - lo);     \
        const int nfirst = (STAGGER && (rk & 1)) ? nfine : 0;     \
        if (fine && rk >= lo) { if (wide) sg3_phase<pg8::EPI, 128, 128>(L + RING_OFF, g.A + (size_t)MP * g.lda, g.Bt, g.N, g.K, E, g.lda, t0, 2, rk - lo, nl - lo, 0, nfirst, tid_k); \
                                else sgemm_phase<pg8::EPI>(L + RING_OFF, g.A + (size_t)MP * g.lda, g.Bt, g.N, g.K, E, g.lda, t0, t1 - t0, rk - lo, nl - lo, 0, nfirst, tid_k); } \
        pg8::gemm_phase<pg8::EPI, pg8::GroupOrder, PG8_ALIGN, PG8_SP2>(L + RING_OFF, g, S, E, tid_k); \
        if (fine && rk >= lo) { if (wide) sg3_phase<pg8::EPI, 128, 128>(L + RING_OFF, g.A + (size_t)MP * g.lda, g.Bt, g.N, g.K, E, g.lda, t0, 2, rk - lo, nl - lo, nfirst, 1 << 20, tid_k); \
                                else sgemm_phase<pg8::EPI>(L + RING_OFF, g.A + (size_t)MP * g.lda, g.Bt, g.N, g.K, E, g.lda, t0, t1 - t0, rk - lo, nl - lo, nfirst, 1 << 20, tid_k); } \
    } while (0)

    {
        TID_LOAD();
        LAS float* scr = (LAS float*)(L + RING_OFF + wave * 16384);
        const int gw = vcu * NWAVES + wave, NGW = G * NWAVES;
        constexpr int I0 = 16 * 96, I1 = 16 * 32, I2 = 16 * 128, I3 = 64 * 32, I4 = 16 * 40, I5 = 16 * 32, I6 = 16 * 128, I7 = 64 * 32, NITEMS = I0 + I1 + I2 + I3 + I4 + I5 + I6 + I7;
        for (int it = gw; it < NITEMS; it += NGW) {
            int r = it;
            if (r < I0) { p0_transpose_item<1>(INP(8), D, NZ, WSP(bf16, WS_WIN), INP(5), scr, r, lane); continue; } r -= I0;
            if (r < I1) { p0_transpose_item<0>(INP(13), D, D, WSP(bf16, WS_WO0), nullptr, scr, r, lane); continue; } r -= I1;
            if (r < I2) { p0_transpose_item<0>(INP(19), D, FF, WSP(bf16, WS_WUP0), INP(6), scr, r, lane); continue; } r -= I2;
            if (r < I3) { p0_transpose_item<0>(INP(20), FF, D, WSP(bf16, WS_WDN0), nullptr, scr, r, lane); continue; } r -= I3;
            if (r < I4) { p0_transpose_item<0>(INP(14), D, NQKV, WSP(bf16, WS_WQKV), INP(5) + D, scr, r, lane); continue; } r -= I4;
            if (r < I5) { p0_transpose_item<0>(INP(17), D, D, WSP(bf16, WS_WO1), nullptr, scr, r, lane); continue; } r -= I5;
            if (r < I6) { p0_transpose_item<0>(INP(19) + (size_t)D * FF, D, FF, WSP(bf16, WS_WUP1), INP(6) + D, scr, r, lane); continue; } r -= I6;
            p0_transpose_item<0>(INP(20) + (size_t)FF * D, FF, D, WSP(bf16, WS_WDN1), nullptr, scr, r, lane);
        }
        for (int m0 = gw; m0 < M; m0 += 2 * NGW) {
            const int m1 = m0 + NGW < M ? m0 + NGW : m0;
            const float* xr0 = m0 < MP ? INP(0) + (size_t)m0 * D : INP(1) + (size_t)(m0 - MP) * D; const float* xr1 = m1 < MP ? INP(0) + (size_t)m1 * D : INP(1) + (size_t)(m1 - MP) * D;
            const GAS f32x4* p0 = (const GAS f32x4*)xr0 + lane; const GAS f32x4* p1 = (const GAS f32x4*)xr1 + lane; f32x4 v[4], w[4]; float s = 0.f, t = 0.f;
#pragma unroll
            for (int j = 0; j < 4; ++j) { v[j] = p0[64 * j]; w[j] = p1[64 * j]; }
#pragma unroll
            for (int j = 0; j < 4; ++j) { s += (v[j].x * v[j].x + v[j].y * v[j].y) + (v[j].z * v[j].z + v[j].w * v[j].w); t += (w[j].x * w[j].x + w[j].y * w[j].y) + (w[j].z * w[j].z + w[j].w * w[j].w); }
            s = wave_sum(s); t = wave_sum(t); if (lane == 0) { ROWSS(0)[m0] = s; ROWSS(0)[m1] = t; }
            GAS unsigned long long* o0 = (GAS unsigned long long*)(WSP(bf16, WS_HB) + (size_t)m0 * D) + lane; GAS unsigned long long* o1 = (GAS unsigned long long*)(WSP(bf16, WS_HB) + (size_t)m1 * D) + lane;
#pragma unroll
            for (int j = 0; j < 4; ++j) { o0[64 * j] = (unsigned long long)pk2(v[j].x, v[j].y) | ((unsigned long long)pk2(v[j].z, v[j].w) << 32); o1[64 * j] = (unsigned long long)pk2(w[j].x, w[j].y) | ((unsigned long long)pk2(w[j].z, w[j].w) << 32); }
        }
        const int gt = vcu * (NWAVES * 64) + tid, NT = G * NWAVES * 64;
        for (int idx = gt; idx < ROPE_ROWS * 64; idx += NT) { const int trow = idx >> 6, j = idx & 63, pos = trow < SEQ ? trow : 16384 + (trow - SEQ); float c, s; rope_entry(pos, j, c, s); ROPEC[idx] = c; ROPES[idx] = s; }
        for (int idx = gt; idx < 4 * 128 * 128; idx += NT) { const int i = (idx >> 7) & 127, j = idx & 127; WSP(bf16, WS_WSB)[idx] = j <= i ? (bf16)f2bf(INP(9)[idx]) : (bf16)0; }
        xcd_barrier(bar);
    }
    if (tid_k == 0) { const unsigned nlx = MISC[8], nx = MISC[9], rkx = MISC[10], gx = MISC[11];
        const unsigned nsub = (nx * NSUB <= 16u && nlx >= NSUB) ? NSUB : 1u, sub = rkx * nsub / nlx, first = (sub * nlx + nsub - 1u) / nsub, nxt = ((sub + 1u) * nlx + nsub - 1u) / nsub;
        MISC[12] = nxt - first; MISC[13] = nx * nsub; MISC[14] = rkx - first; MISC[15] = gx * nsub + sub; MISC[16] = gx * nsub + sub; }
    __syncthreads();
    if (SKEW_TICKS) { GRP_LOAD(); const unsigned long long t_s = __builtin_amdgcn_s_memrealtime(); while (__builtin_amdgcn_s_memrealtime() - t_s < (unsigned long long)(gi * SKEW_TICKS)) __builtin_amdgcn_s_sleep(8); }

    GEMM_PHASE(EpiAB, ({WSP(bf16, WS_Z), ROWSS(0), ROPEC, ROPES}), WSP(bf16, WS_HB), D, WSP(bf16, WS_WIN), NZ, D);
    LBAR();
    {
        TID_LOAD(); GRP_LOAD();
        bf16* const Z = WSP(bf16, WS_Z); bf16* const OC = WSP(bf16, WS_OC); bf16* const SIMG = WSP(bf16, WS_SIMG);
        const int nb = b1 - b0, nstate = 8 * nb;
        for (int uid = rk; uid < nstate; uid += nl) { const int b = b0 + (uid >> 3), h = (uid >> 1) & 3, half = uid & 1;
            ret_state_unit(Z, SIMG, out + OUT_RETP + (size_t)(b * 4 + h) * 16384, b, h, half, L, tid); }
        const bool split = nl > nstate && nl == 2 * nstate && (64 * nb) % nl == 0;
        for (int it = 0; ; ++it) { int uid;
            if (split) { const int per = 64 * nb / nl * 2, ks = rk < nstate ? 3 : 5, base = (rk < nstate ? rk : rk - nstate) * per + (rk < nstate ? 0 : 3 * per / 8); if (it >= ks * per / 8) break; uid = base + it; }
            else { uid = rk + it * nl; if (uid >= 64 * nb) break; }
            const int b = b0 + (uid >> 6), n = (uid >> 2) & 15, g = uid & 3;
            gm_unit_mfma(Z, OC, WSP(bf16, WS_WSB), INP(10), INP(11), INP(12), (size_t)b * SEQ + n * 128, g, L, tid); }
        { const int lo = nl > nstate ? nstate : 0;
          if (rk >= lo) for (int su = rk - lo; su < 4 * (d1 - d0); su += nl - lo) { const int db = d0 + (su >> 2), h = su & 3;
            sample_unit(Z, OC, db, h, INP(2) + (size_t)(db * 4 + h) * 16384, out + OUT_RETS + (size_t)(db * 4 + h) * 16384, out + OUT_GMS + (size_t)db * 8 * 512, INP(9), INP(10), INP(11), INP(12), sm, tid); } }
        LBAR();
        ret_out_phase(Z, OC, SIMG, b0, nb, rk, nl, L, tid);
    }
    LBAR();
    GEMM_PHASE(EpiRes, ({WSP(bf16, WS_HB), ROWSS(1), nullptr}), WSP(bf16, WS_OC), BP, WSP(bf16, WS_WO0), D, D);
    LBAR();
    GEMM_PHASE(EpiUp, ({WSP(bf16, WS_BIG), ROWSS(1)}), WSP(bf16, WS_HB), D, WSP(bf16, WS_WUP0), FF, D);
    LBAR();
    GEMM_PHASE(EpiRes, ({WSP(bf16, WS_HB), ROWSS(2), nullptr}), WSP(bf16, WS_BIG), BP, WSP(bf16, WS_WDN0), D, FF);
    LBAR();
    GEMM_PHASE(EpiQKV, ({WSP(bf16, WS_QKV), ROWSS(2), INP(15), out + OUT_CKP, out + OUT_CKS}), WSP(bf16, WS_HB), D, WSP(bf16, WS_WQKV), NQKV, D);
    {
        TID_LOAD(); GRP_LOAD();
        const int nrem6 = (8 * (b1 - b0) * (NQKV / 256)) % nl, lo6 = (nrem6 && nl > nrem6) ? nrem6 : 0;
        if (rk >= lo6) { const int ndb = d1 - d0, nmine = 2 * ndb * 3840, NTq = (nl - lo6) * NWAVES * 64;
            for (int i0 = (rk - lo6) * NWAVES * 64 + tid; i0 < nmine; i0 += 4 * NTq) { f32x4 cv[4];
#pragma unroll
                for (int u = 0; u < 4; ++u) { const int idx = i0 + u * NTq; if (idx < nmine) { const int which = idx / (ndb * 3840), rem = idx % (ndb * 3840), db = d0 + rem / 3840, o4 = rem % 3840;
                    cv[u] = *((const f32x4*)((which ? INP(4) : INP(3)) + (size_t)db * 16384 + 1024) + o4); } }
#pragma unroll
                for (int u = 0; u < 4; ++u) { const int idx = i0 + u * NTq; if (idx < nmine) { const int which = idx / (ndb * 3840), rem = idx % (ndb * 3840), db = d0 + rem / 3840, o4 = rem % 3840;
                    *((f32x4*)(out + (which ? OUT_CVS : OUT_CKS) + (size_t)db * 16384) + o4) = cv[u]; } } } }
    }
    LBAR();
    {
        TID_LOAD(); GRP_LOAD();
        bf16* const QKV = WSP(bf16, WS_QKV); bf16* const AO = WSP(bf16, WS_AO); const float* const swa_sinks = INP(16); const float* const cache_k = INP(3); const float* const cache_v = INP(4);
        const int c = lane & 15, np = 32 * (b1 - b0), ns = 2 * (d1 - d0);
        for (int uid = rk; uid < np + ns; uid += nl) {
            if (uid < np) { const int b = b0 + (uid >> 5), n = (uid >> 1) & 15, kvh = uid & 1;
#pragma unroll
                for (int i = 0; i < 4; ++i) { const int idx = tid + 512 * i, row = idx >> 3, ch = idx & 7, tok = n * 128 - 128 + row; v4u kk = (v4u){0u, 0u, 0u, 0u}, vv = kk;
                    if (tok >= 0) { const bf16* src = QKV + (size_t)(b * SEQ + tok) * BP + 1024 + kvh * 64 + ch * 8; kk = *(const v4u*)src; vv = *(const v4u*)(src + 128); }
                    *(LAS v4u*)(L + A_K + row * A_KST + ch * 16) = kk; *(LAS v4u*)(L + A_V + row * A_KST + ch * 16) = vv; }
                __syncthreads();
                { const int head = kvh * 8 + wave; const float sink2 = swa_sinks[head] * LOG2E; const int g8 = 8 * (lane >> 4);
                  const bf16* qb = QKV + (size_t)(b * SEQ + n * 128 + c) * BP + head * 64 + g8;
                  bf16x8 qc0 = *(const bf16x8*)qb, qc1 = *(const bf16x8*)(qb + 32);
#pragma unroll 1
                  for (int qt = 0; qt < 8; ++qt) { const size_t row = (size_t)(b * SEQ + n * 128 + 16 * qt + c);
                      const bf16* qn = qb + (size_t)(qt < 7 ? 16 * (qt + 1) : 0) * BP; const bf16x8 qn0 = *(const bf16x8*)qn, qn1 = *(const bf16x8*)(qn + 32);
                      if (n > 0) attn_tile_mfma<true>(qc0, qc1, AO + row * BP + head * 64, 16 * qt + c, sink2, qt >> 1, 0, qt & 1, L, lane);
                      else attn_tile_mfma<false>(qc0, qc1, AO + row * BP + head * 64, 16 * qt + c, sink2, qt >> 1, 128, 0, L, lane);
                      qc0 = qn0; qc1 = qn1; } }
                __syncthreads();
            } else { const int su = uid - np, db = d0 + (su >> 1), kvh = su & 1;
                for (int idx = tid; idx < 160 * 8; idx += 512) { const int row = idx >> 3, ch = idx & 7; v4u kk = (v4u){0u, 0u, 0u, 0u}, vv = kk;
                    if (row < 128) { const float* sk_ = cache_k + (size_t)(db * 128 + row) * 128 + kvh * 64 + ch * 8; const float* sv_ = cache_v + (size_t)(db * 128 + row) * 128 + kvh * 64 + ch * 8;
                        const f32x4 k0 = *(const f32x4*)sk_, k1 = *(const f32x4*)(sk_ + 4), v0 = *(const f32x4*)sv_, v1 = *(const f32x4*)(sv_ + 4);
                        kk = (v4u){pk2(k0[0], k0[1]), pk2(k0[2], k0[3]), pk2(k1[0], k1[1]), pk2(k1[2], k1[3])}; vv = (v4u){pk2(v0[0], v0[1]), pk2(v0[2], v0[3]), pk2(v1[0], v1[1]), pk2(v1[2], v1[3])}; }
                    else if (row < 136) { const bf16* src = QKV + (size_t)(MP + db * 8 + row - 128) * BP + 1024 + kvh * 64 + ch * 8; kk = *(const v4u*)src; vv = *(const v4u*)(src + 128); }
                    *(LAS v4u*)(L + A_K + row * A_KST + ch * 16) = kk; *(LAS v4u*)(L + A_V + row * A_KST + ch * 16) = vv; }
                __syncthreads();
                if (wave < 4) { const int rho = 16 * wave + c, head = kvh * 8 + (rho >> 3), i = rho & 7; const size_t row = (size_t)(MP + db * 8 + i);
                    const bf16* qp = QKV + row * BP + head * 64 + 8 * (lane >> 4);
                    attn_tile_mfma<false>(*(const bf16x8*)qp, *(const bf16x8*)(qp + 32), AO + row * BP + head * 64, i, swa_sinks[head] * LOG2E, 0, 0, 0, L, lane); }
                __syncthreads();
            }
        }
    }
    LBAR();
    GEMM_PHASE(EpiResB, ({WSP(bf16, WS_HB), ROWSS(3), INP(18)}), WSP(bf16, WS_AO), BP, WSP(bf16, WS_WO1), D, D);
    LBAR();
    GEMM_PHASE(EpiUp, ({WSP(bf16, WS_BIG), ROWSS(3)}), WSP(bf16, WS_HB), D, WSP(bf16, WS_WUP1), FF, D);
    LBAR();
    bool fusefin;
    { GRP_LOAD(); fusefin = FUSE_FIN && nl == 32 && (b1 - b0) * 8 * (D / 256) == 2 * nl; }
    if (fusefin) { GRP_LOAD();
        pg8::Gemm g{WSP(bf16, WS_BIG), WSP(bf16, WS_WDN1), MP, D, FF, BP}; pg8::GroupOrder S{8 * b0, 8 * (b1 - b0), D / 256, nl, rk};
        pg8::EpiResFin EF{WSP(bf16, WS_HB), ROWSS(4), (unsigned*)(ctl + CW_FIN), INP(7), out, (unsigned*)(ctl + CW_BAR) + XB_TMO};
        pg8::EpiRes E{WSP(bf16, WS_HB), ROWSS(4), nullptr};
        const int nfine = ((t1 - t0) * (D / 64) + nl - 1) / nl, nfirst = (STAGGER && (rk & 1)) ? nfine : 0;
        sgemm_phase<pg8::EpiRes>(L + RING_OFF, g.A + (size_t)MP * g.lda, g.Bt, g.N, g.K, E, g.lda, t0, t1 - t0, rk, nl, 0, nfirst, tid_k);
        pg8::gemm_phase<pg8::EpiResFin, pg8::GroupOrder, PG8_ALIGN, PG8_SP2>(L + RING_OFF, g, S, EF, tid_k);
        sgemm_phase<pg8::EpiRes>(L + RING_OFF, g.A + (size_t)MP * g.lda, g.Bt, g.N, g.K, E, g.lda, t0, t1 - t0, rk, nl, nfirst, 1 << 20, tid_k);
    } else {
        GEMM_PHASE(EpiRes, ({WSP(bf16, WS_HB), ROWSS(4), nullptr}), WSP(bf16, WS_BIG), BP, WSP(bf16, WS_WDN1), D, FF);
    }
    LBAR();
    {
        TID_LOAD(); GRP_LOAD();
        const float* rs4 = ROWSS(4); const float* const norm_final = INP(7);
        const int np = fusefin ? 0 : SEQ * (b1 - b0), ns = 8 * (d1 - d0);
        for (int i = rk * NWAVES + wave; i < np + ns; i += nl * NWAVES) {
            const int m = i < np ? b0 * SEQ + i : MP + 8 * d0 + (i - np);
            const float rstd = 1.0f / sqrtf(rs4[m] * (1.0f / 1024.0f) + 1e-6f);
            GAS f32x4* yr = (GAS f32x4*)(out + (size_t)m * D) + lane; const GAS f32x4* gr = (const GAS f32x4*)norm_final + lane;
            const GAS unsigned long long* h8 = (const GAS unsigned long long*)(WSP(bf16, WS_HB) + (size_t)m * D) + lane;
#pragma unroll
            for (int j = 0; j < 4; ++j) { const unsigned long long hw = h8[64 * j]; const unsigned lo = (unsigned)hw, hi = (unsigned)(hw >> 32);
                const f32x4 hv = (f32x4){__uint_as_float(lo << 16), __uint_as_float(lo & 0xffff0000u), __uint_as_float(hi << 16), __uint_as_float(hi & 0xffff0000u)};
                yr[64 * j] = hv * rstd * gr[64 * j]; }
        }
    }
}

extern "C" void kernel_launch(void* const* d_in, const int* in_sizes, int n_in, void* d_out, int out_size, void* d_ws, size_t ws_size, hipStream_t stream) {
    static int grid = 0;
    if (grid == 0) {
        if (n_in != 21 || in_sizes[0] != MP * D || (size_t)out_size != OUT_END || ws_size < WS_END) { fprintf(stderr, "kernel_launch: unexpected shapes (n_in %d, in0 %d, out %d, ws %zu); nothing launched\n", n_in, n_in > 0 ? in_sizes[0] : -1, out_size, ws_size); grid = -1; return; }
        int dev = 0, cus = 0, per_cu = 0;
        if (hipGetDevice(&dev) != hipSuccess || hipDeviceGetAttribute(&cus, hipDeviceAttributeMultiprocessorCount, dev) != hipSuccess) { fprintf(stderr, "kernel_launch: device query failed\n"); grid = -1; return; }
        if (hipFuncSetAttribute((const void*)fwd_kernel, hipFuncAttributeMaxDynamicSharedMemorySize, LDS_BYTES) != hipSuccess) { fprintf(stderr, "kernel_launch: hipFuncSetAttribute failed\n"); grid = -1; return; }
        if (hipOccupancyMaxActiveBlocksPerMultiprocessor(&per_cu, (const void*)fwd_kernel, NWAVES * 64, LDS_BYTES) != hipSuccess || per_cu < 1) fprintf(stderr, "kernel_launch: note: occupancy query reports %d workgroups per CU\n", per_cu);
        (void)hipGetLastError();
        grid = cus;
    }
    if (grid < 0) return;
    if (hipMemsetAsync((char*)d_ws + WS_CTL, 0, CTL_ZERO_BYTES, stream) != hipSuccess) { fprintf(stderr, "kernel_launch: hipMemsetAsync failed\n"); return; }
    Args a{};
    for (int i = 0; i < 21; ++i) a.in[i] = (const float*)d_in[i];
    a.out = (float*)d_out; a.ws = (unsigned char*)d_ws;
    hipLaunchKernelGGL(fwd_kernel, dim3(grid), dim3(NWAVES * 64), LDS_BYTES, stream, a);
    const hipError_t le = hipPeekAtLastError();
    if (le != hipSuccess) fprintf(stderr, "kernel_launch: launch failed: %s\n", hipGetErrorName(le));
}
```

```cpp
#define FINE128 0
#define GB_EARLY_INV 1
#include <hip/hip_runtime.h>
#include <cstdio>
#include <cstdint>
namespace pg8 {
#define PG8_LAS __attribute__((address_space(3)))
typedef unsigned short bf16_t;
typedef short bf16x8 __attribute__((ext_vector_type(8)));
typedef float f32x4 __attribute__((ext_vector_type(4)));
typedef unsigned u32x4 __attribute__((ext_vector_type(4)));
constexpr int BM = 256, BK = 64, HALF = 128, HTB = HALF * BK * 2  , STAGE_BYTES = 8 * HTB, NXCD = 8, WGM = 8;

__host__ __device__ __forceinline__ int lds_byte(int r, int c) { const int st = (r >> 4) * 2 + (c >> 5), rr = r & 15, cc = c & 31, ob = rr * 64 + cc * 2; return st * 1024 + (ob ^ (((ob >> 9) & 1) << 5)); }
__host__ __device__ __forceinline__ void stage_rc(int b, int& R, int& C) { const int st = b / 1024, sb = b % 1024, swz = sb ^ (((sb >> 9) & 1) << 5); R = (st >> 1) * 16 + swz / 64; C = (st & 1) * 32 + (swz % 64) / 2; }
__host__ __device__ __forceinline__ int perm32(int rho) { const int n = rho >> 4, i = rho & 15; return 8 * (i >> 2) + 4 * n + (i & 3); }

struct Unit { int pm, pn; };
struct Gemm { const bf16_t* A; const bf16_t* Bt; int M, N, K, lda; };

struct StaticOrder {
    int nM, nN, nwg, G, c;
    __host__ __device__ void init(int M, int N, int G_, int c_) { nM = M / BM; nN = N / BM; nwg = nM * nN; G = G_; c = c_; }
    __host__ __device__ bool next(int i, Unit& u) const {
        const long L = (long)i * G + c; if (L >= nwg) return false;
        int wgid = (int)L; { const int q = nwg / NXCD, r = nwg % NXCD, xcd = wgid % NXCD, off = wgid / NXCD; wgid = (xcd < r ? xcd * (q + 1) : r * (q + 1) + (xcd - r) * q) + off; }
        const int nig = WGM * nN, gid = wgid / nig, fm = gid * WGM, gsz = (nM - fm) < WGM ? (nM - fm) : WGM;
        u.pm = fm + ((wgid % nig) % gsz); u.pn = (wgid % nig) / gsz; return true;
    }
    __device__ __forceinline__ void a_ready(const Unit&) const {}
    __device__ __forceinline__ void done(const Unit&) const {}
};

__device__ __forceinline__ unsigned cvt_pk_bf16(float lo, float hi) { unsigned r; asm volatile("v_cvt_pk_bf16_f32 %0, %1, %2" : "=v"(r) : "v"(lo), "v"(hi)); return r; }
typedef float f32x2 __attribute__((ext_vector_type(2)));
__device__ __forceinline__ f32x2 gelu_pk(f32x2 v) {
    const f32x2 av = __builtin_elementwise_abs(v), d = av * 0.2316418882f + 1.0f;
    f32x2 t; t.x = __builtin_amdgcn_rcpf(d.x); t.y = __builtin_amdgcn_rcpf(d.y);
    f32x2 q = t * 0.5307027145f + (-0.7265760135f); q = q * t + 0.7107068705f; q = q * t + (-0.142248368f); q = q * t + 0.127414796f; q = q * t;
    const f32x2 s = (v * v) * (-0.72134752044f);
    f32x2 e; e.x = __builtin_amdgcn_exp2f(s.x); e.y = __builtin_amdgcn_exp2f(s.y);
    const f32x2 m = v * (q * e), r = v - m;
    f32x2 o; o.x = v.x < 0.f ? m.x : r.x; o.y = v.y < 0.f ? m.y : r.y; return o;
}

#ifndef PG8_PEEL
#define PG8_PEEL 1
#endif
template <class Epi, class Sched, bool ALIGN_EPI = false, bool SP2 = false>
__device__ __forceinline__ void gemm_phase(PG8_LAS unsigned char* lds, const Gemm g, const Sched& S, const Epi& E, int& tid_io) {
    int tid_l = tid_io; asm volatile("" : "+v"(tid_l));
    const int tid = tid_l, wid = __builtin_amdgcn_readfirstlane(tid >> 6), lane = tid & 63, wr = wid >> 2, wc = wid & 3, fr = lane & 15, fq = lane >> 4;
    const int K = g.K, nt = K / BK;
    unsigned voffA, voffB;
    { int R, C; stage_rc(tid * 16, R, C); const int Rb = Epi::PERM ? ((R & ~31) + perm32(R & 31)) : R;
      voffA = (unsigned)(R * g.lda + C) * 2u; voffB = (unsigned)(Rb * K + C) * 2u; }
    const unsigned p2offA = 64u * (unsigned)g.lda * 2u, p2offB = 64u * (unsigned)K * 2u;
    const size_t kstep = (size_t)(BK * 2);
    const size_t hstep = (size_t)HALF * K * 2;
    const size_t hstepA = (size_t)HALF * g.lda * 2, tstepA = 2 * hstepA;
    const size_t tstep = 2 * hstep;
    const unsigned ldsw = (unsigned)wid * 1024u;
    const int aoff = lds_byte(wr * 64 + fr, fq * 8), boff = lds_byte(wc * 32 + fr, fq * 8);
#define PG8_SA(b, h) (((b) * 2 + (h)) * HTB)
#define PG8_SB(b, h) ((4 + (b) * 2 + (h)) * HTB)
#define PG8_STAGE(bufoff, gbase, voff) do { _Pragma("unroll") for (int _i = 0; _i < 2; ++_i) \
        { unsigned vo_ = v##voff; if (_i) asm volatile("v_add_u32 %0, %1, %2" : "=v"(vo_) : "v"(v##voff), "s"(p2##voff));     \
          __builtin_amdgcn_global_load_lds((const unsigned*)((const char*)(gbase) + vo_), (PG8_LAS unsigned*)(lds + (bufoff) + ldsw + _i * 8192), 16, 0, 0); } } while (0)
#define PG8_LDA(dst, b, h) do { _Pragma("unroll") for (int m = 0; m < 4; ++m) _Pragma("unroll") for (int k = 0; k < 2; ++k) dst[m][k] = *(const PG8_LAS bf16x8*)(lds + PG8_SA(b, h) + aoff + m * 2048 + k * 1024); } while (0)
#define PG8_LDB(dst, b, h) do { _Pragma("unroll") for (int n = 0; n < 2; ++n) _Pragma("unroll") for (int k = 0; k < 2; ++k) dst[n][k] = *(const PG8_LAS bf16x8*)(lds + PG8_SB(b, h) + boff + n * 2048 + k * 1024); } while (0)
#define PG8_MMA(ai, bj, At, Bt) do { __builtin_amdgcn_s_setprio(1); _Pragma("unroll") for (int m = 0; m < 4; ++m) _Pragma("unroll") for (int n = 0; n < 2; ++n) _Pragma("unroll") for (int k = 0; k < 2; ++k) \
        acc[ai][bj][m][n] = __builtin_amdgcn_mfma_f32_16x16x32_bf16(Bt[n][k], At[m][k], acc[ai][bj][m][n], 0, 0, 0); __builtin_amdgcn_s_setprio(0); } while (0)
#define PG8_WAIT_V(n) asm volatile("s_waitcnt vmcnt(" #n ")" ::: "memory")
#define PG8_WAIT_L(n) asm volatile("s_waitcnt lgkmcnt(" #n ")" ::: "memory")
#define PG8_BAR __builtin_amdgcn_s_barrier()
#define PG8_SCHED __builtin_amdgcn_sched_barrier(0)
    Unit cur, nxt; int ui = 0;
    if (!S.next(0, cur)) return;
    f32x4 acc[2][2][4][2];
    [[maybe_unused]] u32x4 hraw[2][4][2];
    if constexpr (Epi::ACC_INIT) E.load_h(hraw, cur, wr, wc);
    else {
#pragma unroll
    for (int a = 0; a < 2; ++a)
#pragma unroll
        for (int b = 0; b < 2; ++b)
#pragma unroll
            for (int m = 0; m < 4; ++m)
#pragma unroll
                for (int n = 0; n < 2; ++n) acc[a][b][m][n] = (f32x4){0.f, 0.f, 0.f, 0.f};
    }
    bf16x8 At[4][2], B0[2][2], B1[2][2];
    const char* cA = (const char*)g.A + (size_t)cur.pm * tstepA; const char* cB = (const char*)g.Bt + (size_t)cur.pn * tstep;
    S.a_ready(cur);
    if constexpr (SP2) {
        PG8_STAGE(PG8_SB(0, 0), cB, offB); PG8_STAGE(PG8_SB(0, 1), cB + hstep, offB); PG8_STAGE(PG8_SA(0, 0), cA, offA); PG8_STAGE(PG8_SA(0, 1), cA + hstepA, offA);
        if (wr == 1) PG8_BAR;
        PG8_WAIT_V(2); PG8_BAR;
        PG8_STAGE(PG8_SB(1, 0), cB + kstep, offB); PG8_STAGE(PG8_SA(1, 0), cA + kstep, offA); PG8_STAGE(PG8_SB(1, 1), cB + hstep + kstep, offB);
        PG8_WAIT_V(6); PG8_BAR;
    } else {
        PG8_STAGE(PG8_SB(0, 0), cB, offB); PG8_STAGE(PG8_SA(0, 0), cA, offA); PG8_STAGE(PG8_SB(0, 1), cB + hstep, offB); PG8_STAGE(PG8_SA(0, 1), cA + hstepA, offA);
        if (wr == 1) PG8_BAR;
        PG8_WAIT_V(4); PG8_BAR;
        PG8_STAGE(PG8_SB(1, 0), cB + kstep, offB); PG8_STAGE(PG8_SA(1, 0), cA + kstep, offA); PG8_STAGE(PG8_SB(1, 1), cB + hstep + kstep, offB);
        PG8_WAIT_V(6); PG8_BAR;
    }
    if constexpr (Epi::ACC_INIT) E.unpack(acc, hraw);
    for (;;) {
        const bool has_next = S.next(ui + 1, nxt);
        const char* nA = has_next ? (const char*)g.A + (size_t)nxt.pm * tstepA : cA; const char* nB = has_next ? (const char*)g.Bt + (size_t)nxt.pn * tstep : cB;
        int t0 = 0;
        if constexpr (PG8_PEEL && ALIGN_EPI && SP2) { if (ui > 0) {
            const char* a2 = cA + 2 * kstep; const char* b2 = cB + 2 * kstep; const char* a3 = a2 + kstep; const char* b3 = b2 + kstep;
            PG8_LDB(B0, 0, 0); PG8_LDB(B1, 0, 1); PG8_SCHED; PG8_LDA(At, 0, 0);
            PG8_WAIT_V(24); PG8_WAIT_L(0); PG8_BAR; PG8_MMA(0, 0, At, B0); PG8_MMA(0, 1, At, B1); PG8_BAR; PG8_SCHED;
            PG8_LDA(At, 0, 1); PG8_STAGE(PG8_SB(0, 0), b2, offB); PG8_STAGE(PG8_SB(0, 1), b2 + hstep, offB); PG8_STAGE(PG8_SA(0, 0), a2, offA);
            PG8_WAIT_V(24); PG8_WAIT_L(0); PG8_BAR; PG8_MMA(1, 0, At, B0); PG8_MMA(1, 1, At, B1); PG8_BAR; PG8_SCHED;
            PG8_LDB(B0, 1, 0); PG8_LDB(B1, 1, 1); PG8_SCHED; PG8_LDA(At, 1, 0); PG8_STAGE(PG8_SA(0, 1), a2 + hstepA, offA);
            PG8_WAIT_V(24); PG8_WAIT_L(0); PG8_BAR; PG8_MMA(0, 0, At, B0); PG8_MMA(0, 1, At, B1); PG8_BAR; PG8_SCHED;
            PG8_LDA(At, 1, 1); PG8_STAGE(PG8_SB(1, 0), b3, offB); PG8_STAGE(PG8_SB(1, 1), b3 + hstep, offB); PG8_STAGE(PG8_SA(1, 0), a3, offA);
            PG8_WAIT_V(8); PG8_WAIT_L(0); PG8_BAR; PG8_MMA(1, 0, At, B0); PG8_MMA(1, 1, At, B1); PG8_BAR; PG8_SCHED;
            t0 = 2;
        } }
        for (int t = t0; t < nt; t += 2) {
            const bool last = (t == nt - 2);
            const char* a1 = cA + (size_t)(t + 1) * kstep;
            const char* a2 = last ? nA : cA + (size_t)(t + 2) * kstep; const char* b2 = last ? nB : cB + (size_t)(t + 2) * kstep;
            const char* a3 = a2 + kstep; const char* b3 = b2 + kstep;
            if (last && has_next) S.a_ready(nxt);
            if constexpr (Epi::PRE_LDS) { if (t == nt - 4) {
                int ln_; asm volatile("v_mbcnt_lo_u32_b32 %0, -1, 0\n\tv_mbcnt_hi_u32_b32 %0, -1, %0" : "=v"(ln_));
                const float* gp = E.rowss + cur.pm * BM + wr * 64 + ln_;
                __builtin_amdgcn_global_load_lds((const unsigned*)gp, (PG8_LAS unsigned*)(lds + STAGE_BYTES + wid * 512), 4, 0, 0);
                __builtin_amdgcn_global_load_lds((const unsigned*)(gp + HALF), (PG8_LAS unsigned*)(lds + STAGE_BYTES + wid * 512 + 256), 4, 0, 0); } }
            if constexpr (SP2) {
            PG8_LDB(B0, 0, 0); PG8_LDB(B1, 0, 1); PG8_SCHED; PG8_LDA(At, 0, 0); PG8_STAGE(PG8_SA(1, 1), a1 + hstepA, offA);
            PG8_WAIT_V(8); PG8_WAIT_L(0); PG8_BAR; PG8_MMA(0, 0, At, B0); PG8_MMA(0, 1, At, B1); PG8_BAR; PG8_SCHED;
            PG8_LDA(At, 0, 1); PG8_STAGE(PG8_SB(0, 0), b2, offB); PG8_STAGE(PG8_SB(0, 1), b2 + hstep, offB); PG8_STAGE(PG8_SA(0, 0), a2, offA);
            PG8_WAIT_V(8); PG8_WAIT_L(0); PG8_BAR; PG8_MMA(1, 0, At, B0); PG8_MMA(1, 1, At, B1); PG8_BAR; PG8_SCHED;
            PG8_LDB(B0, 1, 0); PG8_LDB(B1, 1, 1); PG8_SCHED; PG8_LDA(At, 1, 0); PG8_STAGE(PG8_SA(0, 1), a2 + hstepA, offA);
            PG8_WAIT_V(8); PG8_WAIT_L(0); PG8_BAR; PG8_MMA(0, 0, At, B0); PG8_MMA(0, 1, At, B1); PG8_BAR; PG8_SCHED;
            PG8_LDA(At, 1, 1); PG8_STAGE(PG8_SB(1, 0), b3, offB); PG8_STAGE(PG8_SB(1, 1), b3 + hstep, offB); PG8_STAGE(PG8_SA(1, 0), a3, offA);
            PG8_WAIT_V(8); PG8_WAIT_L(0); PG8_BAR; PG8_MMA(1, 0, At, B0); PG8_MMA(1, 1, At, B1); PG8_BAR; PG8_SCHED;
            } else {
            PG8_LDB(B0, 0, 0); PG8_SCHED; PG8_LDA(At, 0, 0); PG8_STAGE(PG8_SA(1, 1), a1 + hstepA, offA);
            PG8_WAIT_L(8); PG8_BAR; PG8_WAIT_L(0); PG8_MMA(0, 0, At, B0); PG8_BAR; PG8_SCHED;
            PG8_LDB(B1, 0, 1); PG8_STAGE(PG8_SB(0, 0), b2, offB);
            PG8_BAR; PG8_WAIT_L(0); PG8_MMA(0, 1, At, B1); PG8_BAR;
            PG8_LDA(At, 0, 1); PG8_STAGE(PG8_SA(0, 0), a2, offA);
            PG8_BAR; PG8_WAIT_L(0); PG8_MMA(1, 0, At, B0); PG8_BAR; PG8_SCHED;
            PG8_STAGE(PG8_SB(0, 1), b2 + hstep, offB);
            PG8_WAIT_V(6); PG8_BAR; PG8_MMA(1, 1, At, B1); PG8_BAR;
            PG8_LDB(B0, 1, 0); PG8_SCHED; PG8_LDA(At, 1, 0); PG8_STAGE(PG8_SA(0, 1), a2 + hstepA, offA);
            PG8_WAIT_L(8); PG8_BAR; PG8_WAIT_L(0); PG8_MMA(0, 0, At, B0); PG8_BAR; PG8_SCHED;
            PG8_LDB(B1, 1, 1); PG8_STAGE(PG8_SB(1, 0), b3, offB);
            PG8_BAR; PG8_WAIT_L(0); PG8_MMA(0, 1, At, B1); PG8_BAR;
            PG8_LDA(At, 1, 1); PG8_STAGE(PG8_SA(1, 0), a3, offA);
            PG8_BAR; PG8_WAIT_L(0); PG8_MMA(1, 0, At, B0); PG8_BAR; PG8_SCHED;
            PG8_STAGE(PG8_SB(1, 1), b3 + hstep, offB);
            PG8_WAIT_V(6); PG8_BAR; PG8_MMA(1, 1, At, B1); PG8_BAR;
            }
        }
        if constexpr (ALIGN_EPI) { if (wr == 0) PG8_BAR; }
        if constexpr (PG8_PEEL && ALIGN_EPI && SP2) { if (has_next) PG8_STAGE(PG8_SA(1, 1), nA + kstep + hstepA, offA); }
        if constexpr (Epi::ACC_INIT) {
            u32x4 hr[4][2];
            PG8_SCHED; if (has_next) E.load_h_half(hr, nxt, wr, wc, 0); PG8_SCHED;
            E.half(acc, cur, wr, wc, 0); PG8_SCHED;
            if (has_next) { E.unpack_half(acc, hr, 0); PG8_SCHED; E.load_h_half(hr, nxt, wr, wc, 1); } PG8_SCHED;
            E.half(acc, cur, wr, wc, 1); PG8_SCHED;
            if (has_next) E.unpack_half(acc, hr, 1); PG8_SCHED;
            S.done(cur);
        } else
        if constexpr (!Epi::AFTER_DRAIN) { E(acc, cur, wr, wc, (const PG8_LAS float*)(lds + STAGE_BYTES) + wid * 128); S.done(cur); }
        if (!has_next) break;
        if constexpr (Epi::ACC_INIT) { }
        else {
#pragma unroll
        for (int a = 0; a < 2; ++a)
#pragma unroll
            for (int b = 0; b < 2; ++b)
#pragma unroll
                for (int m = 0; m < 4; ++m)
#pragma unroll
                    for (int n = 0; n < 2; ++n) acc[a][b][m][n] = (f32x4){0.f, 0.f, 0.f, 0.f};
        }
        cur = nxt; cA = nA; cB = nB; ++ui;
        if constexpr (ALIGN_EPI) { if (wr == 1) PG8_BAR; }
    }
    { int ln_; asm volatile("v_mbcnt_lo_u32_b32 %0, -1, 0\n\tv_mbcnt_hi_u32_b32 %0, -1, %0" : "=v"(ln_)); tid_io = wid * 64 + ln_; }
    PG8_WAIT_V(0);
    if constexpr (!ALIGN_EPI) { if (wr == 0) PG8_BAR; }
    PG8_BAR;
    if constexpr (Epi::AFTER_DRAIN) { E.fused(acc, cur, wr, wc, fr, fq, lds, wid, lane); S.done(cur); }
#undef PG8_SA
#undef PG8_SB
#undef PG8_STAGE
#undef PG8_LDA
#undef PG8_LDB
#undef PG8_MMA
#undef PG8_WAIT_V
#undef PG8_WAIT_L
#undef PG8_BAR
#undef PG8_SCHED
}
}

#ifndef PRELDS_AB
#define PRELDS_AB 1
#endif
#ifndef PRELDS_UP
#define PRELDS_UP 1
#endif
#ifndef PRELDS_QKV
#define PRELDS_QKV 1
#endif
namespace pg8 {
constexpr int MP_ROWS = 32768;
typedef unsigned u32x2 __attribute__((ext_vector_type(2)));
__device__ __forceinline__ unsigned pkbf(float lo, float hi) { typedef float f2_t __attribute__((ext_vector_type(2))); typedef __bf16 b2_t __attribute__((ext_vector_type(2))); f2_t v = {lo, hi}; b2_t b = __builtin_convertvector(v, b2_t); return __builtin_bit_cast(unsigned, b); }
__device__ __forceinline__ u32x4 pk8(f32x4 a, f32x4 b) { u32x4 w; w.x = pkbf(a[0], a[1]); w.y = pkbf(a[2], a[3]); w.z = pkbf(b[0], b[1]); w.w = pkbf(b[2], b[3]); return w; }
__device__ __forceinline__ float silu_f(float x) { return x * __builtin_amdgcn_rcpf(1.0f + __builtin_amdgcn_exp2f(-1.4426950408889634f * x)); }

#define PG8_EPI_DRIVER \
    __device__ __forceinline__ void operator()(const f32x4 (&acc)[2][2][4][2], const Unit& u, int wr, int wc, const PG8_LAS float* pl) const { \
        int ln_; asm volatile("v_mbcnt_lo_u32_b32 %0, -1, 0\n\tv_mbcnt_hi_u32_b32 %0, -1, %0" : "=v"(ln_)); const int fr = ln_ & 15, fq = ln_ >> 4;     \
        const int cb = u.pn * BM + wc * 32 + 8 * fq, rb = u.pm * BM + wr * 64 + fr; \
        float pre[8]; \
        _Pragma("unroll") for (int i = 0; i < 8; ++i) pre[i] = PRE_LDS ? __builtin_amdgcn_rsqf(pl[(i >> 2) * 64 + (i & 3) * 16 + fr] * (1.0f / 1024.0f) + 1e-6f) : rowpre(rb + (i >> 2) * HALF + (i & 3) * 16);     \
        _Pragma("unroll") for (int ai = 0; ai < 2; ++ai) \
        _Pragma("unroll") for (int m = 0; m < 4; ++m) { \
            const int r = rb + ai * HALF + m * 16; float ss = 0.f; \
            _Pragma("unroll") for (int bj = 0; bj < 2; ++bj) ss += apply(r, cb + bj * HALF, acc[ai][bj][m][0], acc[ai][bj][m][1], pre[ai * 4 + m]); \
            if (HAS_POST) { ss += __shfl_xor(ss, 16); ss += __shfl_xor(ss, 32); post(r, ss, fq == 0); } \
            if ((m & (FENCE - 1)) == FENCE - 1) asm volatile("" ::: "memory"); } \
    }

#define PG8_NO_HPRE \
    __device__ __forceinline__ u32x4 hpre(int, int) const { return (u32x4){0u, 0u, 0u, 0u}; } \
    __device__ __forceinline__ float apply_p(int r, int col, f32x4 a0, f32x4 a1, float pre, u32x4) const { return apply(r, col, a0, a1, pre); }
#define PG8_RES_HPRE \
    __device__ __forceinline__ u32x4 hpre(int r, int col) const { return *(const u32x4*)(hb + (size_t)r * 1024 + col); } \
    __device__ __forceinline__ float apply_p(int r, int col, f32x4 a0, f32x4 a1, float, u32x4 hw) const { \
        f32x4 v0 = a0 + (f32x4){__uint_as_float(hw.x << 16), __uint_as_float(hw.x & 0xffff0000u), __uint_as_float(hw.y << 16), __uint_as_float(hw.y & 0xffff0000u)}; \
        f32x4 v1 = a1 + (f32x4){__uint_as_float(hw.z << 16), __uint_as_float(hw.z & 0xffff0000u), __uint_as_float(hw.w << 16), __uint_as_float(hw.w & 0xffff0000u)}; \
        if (bias) { v0 += *(const f32x4*)(bias + col); v1 += *(const f32x4*)(bias + col + 4); } \
        *(u32x4*)(hb + (size_t)r * 1024 + col) = pk8(v0, v1); \
        return (v0[0] * v0[0] + v0[1] * v0[1]) + (v0[2] * v0[2] + v0[3] * v0[3]) + (v1[0] * v1[0] + v1[1] * v1[1]) + (v1[2] * v1[2] + v1[3] * v1[3]); }
#define PG8_RES_HELPERS \
    __device__ __forceinline__ void load_h(u32x4 (&hraw)[2][4][2], const Unit& u, int wr, int wc) const { \
        int ln_; asm volatile("v_mbcnt_lo_u32_b32 %0, -1, 0\n\tv_mbcnt_hi_u32_b32 %0, -1, %0" : "=v"(ln_)); const int fr = ln_ & 15, fq = ln_ >> 4; \
        const bf16_t* hp = hb + (size_t)(u.pm * BM + wr * 64 + fr) * 1024 + u.pn * BM + wc * 32 + 8 * fq; \
        _Pragma("unroll") for (int ai = 0; ai < 2; ++ai) _Pragma("unroll") for (int m = 0; m < 4; ++m) _Pragma("unroll") for (int bj = 0; bj < 2; ++bj) \
            hraw[ai][m][bj] = *(const u32x4*)(hp + (size_t)(ai * HALF + m * 16) * 1024 + bj * HALF); } \
    __device__ __forceinline__ void load_h_half(u32x4 (&hr)[4][2], const Unit& u, int wr, int wc, int ai) const { \
        int ln_; asm volatile("v_mbcnt_lo_u32_b32 %0, -1, 0\n\tv_mbcnt_hi_u32_b32 %0, -1, %0" : "=v"(ln_)); const int fr = ln_ & 15, fq = ln_ >> 4; \
        const bf16_t* hp = hb + (size_t)(u.pm * BM + wr * 64 + fr + ai * HALF) * 1024 + u.pn * BM + wc * 32 + 8 * fq; \
        _Pragma("unroll") for (int m = 0; m < 4; ++m) _Pragma("unroll") for (int bj = 0; bj < 2; ++bj) hr[m][bj] = *(const u32x4*)(hp + (size_t)(m * 16) * 1024 + bj * HALF); } \
    __device__ __forceinline__ void unpack_half(f32x4 (&acc)[2][2][4][2], const u32x4 (&hr)[4][2], int ai) const { \
        _Pragma("unroll") for (int m = 0; m < 4; ++m) _Pragma("unroll") for (int bj = 0; bj < 2; ++bj) { const u32x4 hw = hr[m][bj]; \
            acc[ai][bj][m][0] = (f32x4){__uint_as_float(hw.x << 16), __uint_as_float(hw.x & 0xffff0000u), __uint_as_float(hw.y << 16), __uint_as_float(hw.y & 0xffff0000u)}; \
            acc[ai][bj][m][1] = (f32x4){__uint_as_float(hw.z << 16), __uint_as_float(hw.z & 0xffff0000u), __uint_as_float(hw.w << 16), __uint_as_float(hw.w & 0xffff0000u)}; } } \
    __device__ __forceinline__ void unpack(f32x4 (&acc)[2][2][4][2], const u32x4 (&hraw)[2][4][2]) const { \
        _Pragma("unroll") for (int ai = 0; ai < 2; ++ai) _Pragma("unroll") for (int m = 0; m < 4; ++m) _Pragma("unroll") for (int bj = 0; bj < 2; ++bj) { const u32x4 hw = hraw[ai][m][bj]; \
            acc[ai][bj][m][0] = (f32x4){__uint_as_float(hw.x << 16), __uint_as_float(hw.x & 0xffff0000u), __uint_as_float(hw.y << 16), __uint_as_float(hw.y & 0xffff0000u)}; \
            acc[ai][bj][m][1] = (f32x4){__uint_as_float(hw.z << 16), __uint_as_float(hw.z & 0xffff0000u), __uint_as_float(hw.w << 16), __uint_as_float(hw.w & 0xffff0000u)}; } }

struct EpiAB {
    static constexpr bool PERM = true, AFTER_DRAIN = false, HAS_POST = false, PRE_LDS = (PRELDS_AB != 0), ACC_INIT = false;
    bf16_t* Z; const float* rowss; const float* ropec; const float* ropes;
    static constexpr int FENCE = 4;
    __device__ __forceinline__ void post(int, float, bool) const {}
    PG8_NO_HPRE
    __device__ __forceinline__ float rowpre(int r) const { return __builtin_amdgcn_rsqf(rowss[r] * (1.0f / 1024.0f) + 1e-6f); }
    __device__ __forceinline__ float apply(int r, int col, f32x4 a0, f32x4 a1, float rstd) const {
        const int pn = col >> 8;
        bf16_t* zrow = Z + (size_t)r * 4096;
        if (pn < 4) {
            const bool prompt = r < MP_ROWS; const int ic = prompt ? (r & 127) : (r & 7); const int trow = prompt ? (r & 2047) : 2048 + (r & 7);
            const int d0 = 16 * ((col & 127) >> 5) + 4 * ((col >> 3) & 3), head = (col >> 7) & 3;
            const f32x4 cs = *(const f32x4*)(ropec + trow * 64 + d0), sn = *(const f32x4*)(ropes + trow * 64 + d0);
            const float l2g = head == 0 ? -0.04580368961312479f : head == 1 ? -0.02272007650008353f : head == 2 ? -0.011315313227834146f : -0.005646563141142063f;
            const float e = (float)(ic + 1) * l2g;
            const float sc = rstd * (pn < 2 ? __builtin_amdgcn_exp2f(e) * 0.08838834764831845f : __builtin_amdgcn_exp2f(-e));
            const f32x4 x1 = a0 * sc, x2 = a1 * sc;
            const f32x4 o1 = x1 * cs - x2 * sn, o2 = x2 * cs + x1 * sn;
            u32x2 w1, w2; w1.x = pkbf(o1[0], o1[1]); w1.y = pkbf(o1[2], o1[3]); w2.x = pkbf(o2[0], o2[1]); w2.y = pkbf(o2[2], o2[3]);
            bf16_t* zp = zrow + (col & ~127) + d0;
            *(u32x2*)zp = w1; *(u32x2*)(zp + 64) = w2;
        } else {
            f32x4 v0 = a0 * rstd, v1 = a1 * rstd;
            if (pn >= 8) { f32x2 a = gelu_pk((f32x2){v0[0], v0[1]}), b = gelu_pk((f32x2){v0[2], v0[3]}), c = gelu_pk((f32x2){v1[0], v1[1]}), d = gelu_pk((f32x2){v1[2], v1[3]});
                v0 = (f32x4){a.x, a.y, b.x, b.y}; v1 = (f32x4){c.x, c.y, d.x, d.y}; }
            else if (pn >= 6) { v0 = (f32x4){silu_f(v0[0]), silu_f(v0[1]), silu_f(v0[2]), silu_f(v0[3])}; v1 = (f32x4){silu_f(v1[0]), silu_f(v1[1]), silu_f(v1[2]), silu_f(v1[3])}; }
            *(u32x4*)(zrow + col) = pk8(v0, v1);
        }
        return 0.f;
    }
    PG8_EPI_DRIVER
};
struct EpiRes {
    static constexpr bool PERM = true, AFTER_DRAIN = false, HAS_POST = true, PRE_LDS = false, ACC_INIT = true;
    bf16_t* hb; float* rowss_out; const float* bias;
    static constexpr int FENCE = 4;
    __device__ __forceinline__ void post(int r, float ss, bool lead) const { if (lead) atomicAdd(rowss_out + r, ss); }
    PG8_RES_HPRE
    __device__ __forceinline__ float rowpre(int) const { return 0.f; }
    __device__ __forceinline__ float apply(int r, int col, f32x4 a0, f32x4 a1, float) const {
        bf16_t* hp = hb + (size_t)r * 1024 + col;
        const u32x4 hw = *(const u32x4*)hp;
        f32x4 v0 = a0 + (f32x4){__uint_as_float(hw.x << 16), __uint_as_float(hw.x & 0xffff0000u), __uint_as_float(hw.y << 16), __uint_as_float(hw.y & 0xffff0000u)};
        f32x4 v1 = a1 + (f32x4){__uint_as_float(hw.z << 16), __uint_as_float(hw.z & 0xffff0000u), __uint_as_float(hw.w << 16), __uint_as_float(hw.w & 0xffff0000u)};
        if (bias) { v0 += *(const f32x4*)(bias + col); v1 += *(const f32x4*)(bias + col + 4); }
        *(u32x4*)hp = pk8(v0, v1);
        return (v0[0] * v0[0] + v0[1] * v0[1]) + (v0[2] * v0[2] + v0[3] * v0[3]) + (v1[0] * v1[0] + v1[1] * v1[1]) + (v1[2] * v1[2] + v1[3] * v1[3]);
    }
    PG8_RES_HELPERS
    __device__ __forceinline__ void half(const f32x4 (&acc)[2][2][4][2], const Unit& u, int wr, int wc, int ai) const {
        int ln_; asm volatile("v_mbcnt_lo_u32_b32 %0, -1, 0\n\tv_mbcnt_hi_u32_b32 %0, -1, %0" : "=v"(ln_)); const int fr = ln_ & 15, fq = ln_ >> 4;
        const int cb = u.pn * BM + wc * 32 + 8 * fq, rb = u.pm * BM + wr * 64 + fr;
        f32x4 bb[2][2];
#pragma unroll
        for (int bj = 0; bj < 2; ++bj) { bb[bj][0] = bias ? *(const f32x4*)(bias + cb + bj * HALF) : (f32x4){0.f, 0.f, 0.f, 0.f}; bb[bj][1] = bias ? *(const f32x4*)(bias + cb + bj * HALF + 4) : (f32x4){0.f, 0.f, 0.f, 0.f}; }
        {
#pragma unroll
            for (int m = 0; m < 4; ++m) { const int r = rb + ai * HALF + m * 16; float ss = 0.f;
#pragma unroll
                for (int bj = 0; bj < 2; ++bj) { const f32x4 v0 = acc[ai][bj][m][0] + bb[bj][0], v1 = acc[ai][bj][m][1] + bb[bj][1];
                    *(u32x4*)(hb + (size_t)r * 1024 + cb + bj * HALF) = pk8(v0, v1);
                    ss += (v0[0] * v0[0] + v0[1] * v0[1]) + (v0[2] * v0[2] + v0[3] * v0[3]) + (v1[0] * v1[0] + v1[1] * v1[1]) + (v1[2] * v1[2] + v1[3] * v1[3]); }
                ss += __shfl_xor(ss, 16); ss += __shfl_xor(ss, 32); post(r, ss, fq == 0); }
        }
    }
};
struct EpiUp {
    static constexpr bool PERM = true, AFTER_DRAIN = false, HAS_POST = false, PRE_LDS = (PRELDS_UP != 0), ACC_INIT = false;
    bf16_t* O; const float* rowss;
    static constexpr int FENCE = 4;
    __device__ __forceinline__ void post(int, float, bool) const {}
    PG8_NO_HPRE
    __device__ __forceinline__ float rowpre(int r) const { return __builtin_amdgcn_rsqf(rowss[r] * (1.0f / 1024.0f) + 1e-6f); }
    __device__ __forceinline__ float apply(int r, int col, f32x4 a0, f32x4 a1, float rstd) const {
        f32x4 v0 = a0 * rstd, v1 = a1 * rstd;
#pragma unroll
        for (int e = 0; e < 4; ++e) { const float a = fmaxf(v0[e], 0.f), b = fmaxf(v1[e], 0.f); v0[e] = a * a; v1[e] = b * b; }
        *(u32x4*)(O + (size_t)r * 4096 + col) = pk8(v0, v1);
        return 0.f;
    }
    PG8_EPI_DRIVER
};
struct EpiQKV {
    static constexpr bool PERM = true, AFTER_DRAIN = false, HAS_POST = false, PRE_LDS = (PRELDS_QKV != 0), ACC_INIT = false;
    bf16_t* O; const float* rowss; const float* bias; float* ckp; float* cks;
    static constexpr int FENCE = 4;
    __device__ __forceinline__ void post(int, float, bool) const {}
    PG8_NO_HPRE
    __device__ __forceinline__ float rowpre(int r) const { return __builtin_amdgcn_rsqf(rowss[r] * (1.0f / 1024.0f) + 1e-6f); }
    __device__ __forceinline__ float apply(int r, int col, f32x4 a0, f32x4 a1, float rstd) const {
        const float qs = col < 1024 ? 0.125f * 1.4426950408889634f : 1.0f;
        const f32x4 v0 = (a0 * rstd + *(const f32x4*)(bias + col)) * qs, v1 = (a1 * rstd + *(const f32x4*)(bias + col + 4)) * qs;
        *(u32x4*)(O + (size_t)r * 4096 + col) = pk8(v0, v1);
        if (col >= 1024) {
            float* dst = nullptr; const int isv = (col >> 7) & 1, cc = col & 127;
            if (r < MP_ROWS) { const int t = r & 2047; if (t >= 1920) dst = ckp + (size_t)isv * 262144 + (size_t)((r >> 11) * 128 + t - 1920) * 128 + cc; }
            else { const int s = r - MP_ROWS; dst = cks + (size_t)isv * 2097152 + (size_t)((s >> 3) * 128 + 120 + (s & 7)) * 128 + cc; }
            if (dst) { *(f32x4*)dst = v0; *(f32x4*)(dst + 4) = v1; }
        }
        return 0.f;
    }
    PG8_EPI_DRIVER
};
struct EpiResFin {
    static constexpr bool PERM = true, AFTER_DRAIN = false, PRE_LDS = false, ACC_INIT = false;
    const bf16_t* hb; float* rowss; unsigned* cnt; const float* gfin; float* y; unsigned* tmo;
    __device__ __forceinline__ void operator()(f32x4 (&acc)[2][2][4][2], const Unit& u, int wr, int wc, const PG8_LAS float*) const {
        int ln_; asm volatile("v_mbcnt_lo_u32_b32 %0, -1, 0\n\tv_mbcnt_hi_u32_b32 %0, -1, %0" : "=v"(ln_)); const int fr = ln_ & 15, fq = ln_ >> 4;
        const int cb = u.pn * BM + wc * 32 + 8 * fq, rb = u.pm * BM + wr * 64 + fr;
#pragma unroll
        for (int ai = 0; ai < 2; ++ai)
#pragma unroll
            for (int m = 0; m < 4; ++m) { const int r = rb + ai * HALF + m * 16; float ss = 0.f;
#pragma unroll
                for (int bj = 0; bj < 2; ++bj) { const u32x4 hw = *(const u32x4*)(hb + (size_t)r * 1024 + cb + bj * HALF);
                    const f32x4 v0 = acc[ai][bj][m][0] + (f32x4){__uint_as_float(hw.x << 16), __uint_as_float(hw.x & 0xffff0000u), __uint_as_float(hw.y << 16), __uint_as_float(hw.y & 0xffff0000u)};
                    const f32x4 v1 = acc[ai][bj][m][1] + (f32x4){__uint_as_float(hw.z << 16), __uint_as_float(hw.z & 0xffff0000u), __uint_as_float(hw.w << 16), __uint_as_float(hw.w & 0xffff0000u)};
                    acc[ai][bj][m][0] = v0; acc[ai][bj][m][1] = v1;
                    ss += (v0[0] * v0[0] + v0[1] * v0[1]) + (v0[2] * v0[2] + v0[3] * v0[3]) + (v1[0] * v1[0] + v1[1] * v1[1]) + (v1[2] * v1[2] + v1[3] * v1[3]); }
                ss += __shfl_xor(ss, 16); ss += __shfl_xor(ss, 32);
                if (fq == 0) atomicAdd(rowss + r, ss); }
        asm volatile("s_waitcnt vmcnt(0)" ::: "memory");
        unsigned* cw = cnt + 64 * u.pm;
        if (fr == 0 && fq == 0) __hip_atomic_fetch_add(cw, 1u, __ATOMIC_RELAXED, __HIP_MEMORY_SCOPE_AGENT);
        { unsigned sp = 0;
          while ((unsigned)__builtin_amdgcn_readfirstlane((int)__hip_atomic_load(cw, __ATOMIC_RELAXED, __HIP_MEMORY_SCOPE_AGENT)) < 32u) {
              __builtin_amdgcn_s_sleep(2); if (++sp > (1u << 20)) { if (fr == 0 && fq == 0) __hip_atomic_store(tmo, 1u, __ATOMIC_RELAXED, __HIP_MEMORY_SCOPE_AGENT); break; } } }
        float rs8[8];
#pragma unroll
        for (int i = 0; i < 8; ++i) rs8[i] = __hip_atomic_load(rowss + rb + (i >> 2) * HALF + (i & 3) * 16, __ATOMIC_RELAXED, __HIP_MEMORY_SCOPE_AGENT);
        f32x4 gg[2][2];
#pragma unroll
        for (int bj = 0; bj < 2; ++bj) { gg[bj][0] = *(const f32x4*)(gfin + (cb & 1023) + bj * HALF); gg[bj][1] = *(const f32x4*)(gfin + (cb & 1023) + bj * HALF + 4); }
#pragma unroll
        for (int ai = 0; ai < 2; ++ai)
#pragma unroll
            for (int m = 0; m < 4; ++m) { const int r = rb + ai * HALF + m * 16; const float rstd = 1.0f / sqrtf(rs8[ai * 4 + m] * (1.0f / 1024.0f) + 1e-6f);
#pragma unroll
                for (int bj = 0; bj < 2; ++bj) { float* yp = y + (size_t)r * 1024 + cb + bj * HALF;
                    *(f32x4*)yp = acc[ai][bj][m][0] * rstd * gg[bj][0]; *(f32x4*)(yp + 4) = acc[ai][bj][m][1] * rstd * gg[bj][1]; } }
    }
};
struct GroupOrder {
    int pm0, npm, nN, nl, rk;
    __device__ __forceinline__ bool next(int i, Unit& u) const {
        const int L = i * nl + rk; if (L >= npm * nN) return false;
        const int blk = L / (8 * nN), rem = L - blk * 8 * nN;
        u.pm = pm0 + 8 * blk + (rem & 7); u.pn = rem >> 3; return true;
    }
    __device__ __forceinline__ void a_ready(const Unit&) const {}
    __device__ __forceinline__ void done(const Unit&) const {}
};
}
#ifndef PG8_SP2
#define PG8_SP2 true
#endif
#ifndef PG8_ALIGN
#define PG8_ALIGN true
#endif
#define GAS __attribute__((address_space(1)))
#define LAS __attribute__((address_space(3)))
typedef unsigned short bf16;
typedef unsigned v4u __attribute__((ext_vector_type(4)));
typedef float f32x4 __attribute__((ext_vector_type(4)));
typedef short bf16x8 __attribute__((ext_vector_type(8)));
typedef GAS unsigned gu32;
typedef GAS unsigned long long gu64;
#define RLX_AGENT __ATOMIC_RELAXED, __HIP_MEMORY_SCOPE_AGENT
#define LDS_WAIT() asm volatile("s_waitcnt lgkmcnt(0)" ::: "memory")
#define VM_WAIT() asm volatile("s_waitcnt vmcnt(0)" ::: "memory")
__device__ __forceinline__ unsigned long long rt() { return __builtin_amdgcn_s_memrealtime(); }
__device__ __forceinline__ unsigned f2bf(float f) { unsigned u = __builtin_bit_cast(unsigned, f); return (u + 0x7fffu + ((u >> 16) & 1u)) >> 16; }
__device__ __forceinline__ unsigned pk2(float lo, float hi) { return f2bf(lo) | (f2bf(hi) << 16); }

#define XB_TMO      128
#define XB_XCNT(j)  (256  + 64 * (j))
#define XB_XSUB(j)  (1280 + 64 * (j))
#define XB_XGEN(j)  (2304 + 64 * (j))
#define XB_TOP      3328
#define XB_TOPGEN   3392
#define XCD_BAR_WORDS 3456
#define XB_SPIN_CAP (1u << 18)

__device__ __forceinline__ unsigned xb_ld(unsigned* p)              { return __hip_atomic_load(p, __ATOMIC_RELAXED, __HIP_MEMORY_SCOPE_AGENT); }
__device__ __forceinline__ unsigned xb_add(unsigned* p, unsigned v) { return __hip_atomic_fetch_add(p, v, __ATOMIC_RELAXED, __HIP_MEMORY_SCOPE_AGENT); }
__device__ __forceinline__ unsigned xb_xcc_id() { return (unsigned)__builtin_amdgcn_s_getreg((3 << 11) | 20) & 0xFu; }
#define XB_SPIN(cond, bar) do { unsigned _sp = 0; while (cond) { __builtin_amdgcn_s_sleep(1); \
    if ((++_sp & 255u) == 0u) { if (xb_ld(&(bar)[XB_TMO])) break; if (_sp > XB_SPIN_CAP) { atomicAdd(&(bar)[XB_TMO], 1u); break; } } } } while (0)

struct XcdBarrier {
    unsigned* bar; unsigned x;
    volatile LAS unsigned* st;
};

__device__ __forceinline__ XcdBarrier xcd_barrier_post(unsigned* bar, volatile LAS unsigned* st) {
    XcdBarrier b; b.bar = bar; b.x = xb_xcc_id(); b.st = st;
    if (threadIdx.x == 0) st[2] = xb_add(&bar[XB_XCNT(b.x)], 1u);
    return b;
}
__device__ __forceinline__ void xcd_barrier_complete(unsigned* bar, unsigned x, unsigned& nloc, unsigned& nx, unsigned& gidx) {
    const unsigned G = gridDim.x * gridDim.y * gridDim.z;
    unsigned sum, cnt, mine, sp = 0u;
    for (;;) {
        sum = 0u; cnt = 0u; mine = 0u;
#pragma unroll
        for (unsigned j = 0; j < 16; ++j) { const unsigned c = xb_ld(&bar[XB_XCNT(j)]); sum += c; cnt += (c > 0u) ? 1u : 0u; mine = (j == x) ? c : mine; }
        if (sum == G) break;
        __builtin_amdgcn_s_sleep(1);
        if ((++sp & 255u) == 0u) { if (xb_ld(&bar[XB_TMO])) break; if (sp > XB_SPIN_CAP) { atomicAdd(&bar[XB_TMO], 1u); break; } }
    }
    nloc = mine > 0u ? mine : 1u; nx = cnt > 0u ? cnt : 1u;
    gidx = 0u;
#pragma unroll
    for (unsigned j = 0; j < 16; ++j) if (j < x && xb_ld(&bar[XB_XCNT(j)]) > 0u) ++gidx;
}

__device__ __forceinline__ void xcd_barrier(const XcdBarrier& b) {
    asm volatile("s_waitcnt vmcnt(0)" ::: "memory");
    __syncthreads();
    if (threadIdx.x == 0) {
        unsigned* bar = b.bar;
        __builtin_amdgcn_s_waitcnt(0);
        unsigned nloc = b.st[0], nx = b.st[1];
        if (nloc == 0u) { unsigned gidx; xcd_barrier_complete(bar, b.x, nloc, nx, gidx); b.st[0] = nloc; b.st[1] = nx; b.st[3] = gidx; }
        const unsigned old = xb_add(&bar[XB_XSUB(b.x)], 1u);
        const unsigned gen = old / nloc;
        if (old + 1u == (gen + 1u) * nloc) {
            __builtin_amdgcn_fence(__ATOMIC_RELEASE, "agent");
            asm volatile("s_waitcnt vmcnt(0)" ::: "memory");
            const unsigned og = xb_add(&bar[XB_TOP], 1u);
            const unsigned tg = og / nx;
            if (og + 1u == (tg + 1u) * nx) xb_add(&bar[XB_TOPGEN], 1u);
            else XB_SPIN(xb_ld(&bar[XB_TOPGEN]) == tg, bar);
            __builtin_amdgcn_fence(__ATOMIC_ACQUIRE, "agent");
            xb_add(&bar[XB_XGEN(b.x)], 1u);
            asm volatile("s_waitcnt vmcnt(0)" ::: "memory");
        } else {
            XB_SPIN(xb_ld(&bar[XB_XGEN(b.x)]) == gen, bar);
            __builtin_amdgcn_fence(__ATOMIC_ACQUIRE, "agent");
            asm volatile("s_waitcnt vmcnt(0)" ::: "memory");
        }
    }
    __syncthreads();
}

#define XB_VSUB(j)  (3456 + 64 * (j))
#define XB_VGEN(j)  (5504 + 64 * (j))
#define XCD_BAR_WORDS_V 7552
#ifndef GB_EARLY_INV
#define GB_EARLY_INV 0
#endif
__device__ __forceinline__ void group_barrier(unsigned* bar, volatile LAS unsigned* gst, int tid_in) {
    asm volatile("s_waitcnt vmcnt(0)" ::: "memory");
    __syncthreads();
    if (tid_in == 0) {
        __builtin_amdgcn_s_waitcnt(0);
        const unsigned nloc = gst[0], slot = gst[4];
        const unsigned old = xb_add(&bar[XB_VSUB(slot)], 1u);
#if GB_EARLY_INV
        __builtin_amdgcn_fence(__ATOMIC_ACQUIRE, "agent");
#endif
        const unsigned gen = old / nloc;
        if (old + 1u == (gen + 1u) * nloc) xb_add(&bar[XB_VGEN(slot)], 1u);
        else XB_SPIN(xb_ld(&bar[XB_VGEN(slot)]) == gen, bar);
#if !GB_EARLY_INV
        __builtin_amdgcn_fence(__ATOMIC_ACQUIRE, "agent");
#endif
        asm volatile("s_waitcnt vmcnt(0)" ::: "memory");
    }
    __syncthreads();
}

constexpr int NWAVES = 8;
constexpr int D = 1024, SEQ = 2048, NBATCH = 16, MP = NBATCH * SEQ, NDB = 128, DSEQ = 8, MS = NDB * DSEQ, M = MP + MS, FF = 4096, NZ = 3072, NQKV = 1280;
constexpr int BP = 4096;
constexpr int ROPE_ROWS = SEQ + DSEQ;
constexpr float LOG2E = 1.4426950408889634f;

constexpr size_t MiB = 1u << 20;
constexpr size_t WS_CTL = 0, CTL_ZERO_BYTES = 1 * MiB;
constexpr size_t WS_ROWSS = 256 * 1024;
static_assert(WS_ROWSS + 5 * (size_t)M * 4 <= CTL_ZERO_BYTES && (16384 + 64 * 132) * 4 <= (int)WS_ROWSS, "rowss and the arrival words inside the zeroed region");
constexpr size_t WS_WSB = 4 * MiB;
constexpr size_t WS_ROPE = 2 * MiB;
constexpr size_t WS_WIN = 5 * MiB, WS_WO0 = 11 * MiB, WS_WUP0 = 13 * MiB, WS_WDN0 = 21 * MiB, WS_WQKV = 29 * MiB, WS_WO1 = 32 * MiB, WS_WUP1 = 34 * MiB, WS_WDN1 = 42 * MiB;
constexpr size_t WS_HB = 50 * MiB;
constexpr size_t WS_BIG = 116 * MiB;
constexpr size_t WS_SIMG = 384 * MiB;
constexpr size_t WS_Z = WS_BIG, WS_OC = WS_BIG + 3072 * 2, WS_QKV = WS_BIG, WS_AO = WS_BIG + 3072 * 2, WS_END = 416 * MiB;
static_assert(WS_HB + (size_t)M * D * 2 <= WS_BIG && WS_BIG + (size_t)M * BP * 2 <= WS_SIMG && WS_SIMG + 32 * MiB <= WS_END && NZ <= 3072 && NQKV <= 3072 && 3072 + D <= BP && FF == BP, "d_ws map");
constexpr int CW_FIN = 16384;
constexpr int CW_BAR = 4096;
constexpr size_t OUT_Y = 0, OUT_RETP = (size_t)M * D, OUT_RETS = OUT_RETP + (size_t)NBATCH * 4 * 128 * 128, OUT_GMS = OUT_RETS + (size_t)NDB * 4 * 128 * 128, OUT_CKP = OUT_GMS + (size_t)NDB * DSEQ * 512,
                 OUT_CVP = OUT_CKP + (size_t)NBATCH * 128 * 128, OUT_CKS = OUT_CVP + (size_t)NBATCH * 128 * 128, OUT_CVS = OUT_CKS + (size_t)NDB * 128 * 128, OUT_END = OUT_CVS + (size_t)NDB * 128 * 128;
static_assert(OUT_CVP - OUT_CKP == 262144 && OUT_CVS - OUT_CKS == 2097152, "EpiQKV's v-cache offsets");
constexpr int RING_OFF = 0, SCR_BYTES = 143360, LDSCTL_OFF = SCR_BYTES, MISC_OFF = LDSCTL_OFF + 320, LDS_BYTES = 147456;

__device__ __forceinline__ float bf2f(unsigned short b) { return __uint_as_float(((unsigned)b) << 16); }
__device__ __forceinline__ float wave_sum(float v) {
#pragma unroll
    for (int o = 1; o < 64; o <<= 1) v += __shfl_xor(v, o);
    return v;
}
__device__ __forceinline__ int win_destrow(int n) {
    if (n >= 1024) return n;
    const int d = n & 127, nb = d >> 6, dl = d & 63, wc = dl >> 4, fq = (dl >> 2) & 3, e = dl & 3;
    return (n & ~127) + 32 * wc + 8 * fq + 4 * nb + e;
}
template <int MODE> __device__ __forceinline__ void p0_transpose_item(const float* W, int K, int N, bf16* WT, const float* gain, LAS float* scr, int item, int lane) {
    const int nblk = N / 32, kb = item / nblk, nb = item % nblk, k0 = 64 * kb, n0 = 32 * nb;
    float wv[32];
#pragma unroll
    for (int i = 0; i < 32; ++i) wv[i] = W[(size_t)(k0 + 2 * i + (lane >> 5)) * N + n0 + (lane & 31)];
    if (gain) {
#pragma unroll
        for (int i = 0; i < 32; ++i) wv[i] *= gain[k0 + 2 * i + (lane >> 5)]; }
#pragma unroll
    for (int i = 0; i < 32; ++i) scr[(2 * i + (lane >> 5)) * 33 + (lane & 31)] = wv[i];
    LDS_WAIT(); asm volatile("" ::: "memory");
    const int c = lane & 7;
#pragma unroll
    for (int j = 0; j < 4; ++j) { const int n = (lane >> 3) + 8 * j; const LAS float* s = scr + (8 * c) * 33 + n;
        v4u o; o.x = pk2(s[0 * 33], s[1 * 33]); o.y = pk2(s[2 * 33], s[3 * 33]); o.z = pk2(s[4 * 33], s[5 * 33]); o.w = pk2(s[6 * 33], s[7 * 33]);
        const int dr = MODE ? win_destrow(n0 + n) : (n0 + n);
        *(GAS v4u*)(WT + (size_t)dr * K + k0 + 8 * c) = o; }
    LDS_WAIT(); asm volatile("" ::: "memory");
}
__device__ __forceinline__ void rope_entry(int pos, int j, float& c, float& s) {
    double inv = 1.0, p = 0.8659643233600653;
#pragma unroll
    for (int b = 0; b < 6; ++b) { if ((j >> b) & 1) inv *= p; p *= p; }
    const double rev = (double)pos * inv * 0.15915494309189535;
    const double fr = rev - __builtin_rint(rev);
    const double q = __builtin_rint(fr * 4.0); const double r = (fr - q * 0.25) * 6.283185307179586; const double r2 = r * r;
    double sn = -1.0 / 6227020800.0; sn = sn * r2 + 1.0 / 39916800.0; sn = sn * r2 - 1.0 / 362880.0; sn = sn * r2 + 1.0 / 5040.0; sn = sn * r2 - 1.0 / 120.0; sn = sn * r2 + 1.0 / 6.0; sn = r - r * r2 * sn;
    double cn = 1.0 / 87178291200.0; cn = cn * r2 - 1.0 / 479001600.0; cn = cn * r2 + 1.0 / 3628800.0; cn = cn * r2 - 1.0 / 40320.0; cn = cn * r2 + 1.0 / 720.0; cn = cn * r2 - 1.0 / 24.0; cn = cn * r2 + 0.5; cn = 1.0 - r2 * cn;
    const int qi = ((int)q) & 3;
    const double cc = qi == 0 ? cn : qi == 1 ? -sn : qi == 2 ? -cn : sn, ss = qi == 0 ? sn : qi == 1 ? cn : qi == 2 ? -sn : -cn;
    c = (float)cc; s = (float)ss;
}

__device__ __forceinline__ void ret_unit_naive(const bf16* Z, bf16* OC, int rowbase, int ntok, int cmask, int h, const float* S_in, float* S_out, float gC, float* sm, int tid) {
    const int dv = tid & 127, dq = tid >> 7, lane = tid & 63, wave = tid >> 6;
    float S[32];
#pragma unroll
    for (int kk = 0; kk < 32; ++kk) S[kk] = S_in ? S_in[(dq * 32 + kk) * 128 + dv] : 0.f;
    float* sq = sm; float* sk = sm + 1024; float* sv = sm + 2048; float* red = sm + 3072;
    for (int t0 = 0; t0 < ntok; t0 += 8) {
#pragma unroll
        for (int i = 0; i < 6; ++i) { const int e = tid + 512 * i, arr = e >> 10, rem = e & 1023, tt = rem >> 7, d = rem & 127;
            sm[e] = bf2f(Z[(size_t)(rowbase + t0 + tt) * BP + arr * 512 + h * 128 + d]); }
        __syncthreads();
#pragma unroll 1
        for (int tt = 0; tt < 8; ++tt) {
            const float vv = sv[tt * 128 + dv]; float a = 0.f;
#pragma unroll
            for (int kk = 0; kk < 32; ++kk) { S[kk] = fmaf(sk[tt * 128 + dq * 32 + kk], vv, S[kk]); a = fmaf(sq[tt * 128 + dq * 32 + kk], S[kk], a); }
            red[(tt * 4 + dq) * 128 + dv] = a;
            if (((t0 + tt) & cmask) == cmask) {
#pragma unroll
                for (int kk = 0; kk < 32; ++kk) S[kk] *= gC; }
        }
        __syncthreads();
        { const int tt = wave; const size_t row = (size_t)(rowbase + t0 + tt);
          float o0 = 0.f, o1 = 0.f;
#pragma unroll
          for (int q4 = 0; q4 < 4; ++q4) { o0 += red[(tt * 4 + q4) * 128 + lane]; o1 += red[(tt * 4 + q4) * 128 + lane + 64]; }
          const float ss = wave_sum(o0 * o0 + o1 * o1); const float rs = 1.0f / sqrtf(ss * (1.0f / 128.0f) + 1e-6f);
          const float g0 = bf2f(Z[row * BP + 1536 + h * 128 + lane]), g1 = bf2f(Z[row * BP + 1536 + h * 128 + lane + 64]);
          OC[row * BP + h * 128 + lane] = (bf16)f2bf(o0 * rs * g0); OC[row * BP + h * 128 + lane + 64] = (bf16)f2bf(o1 * rs * g1); }
        __syncthreads();
    }
#pragma unroll
    for (int kk = 0; kk < 32; ++kk) S_out[(dq * 32 + kk) * 128 + dv] = S[kk];
}
__device__ __forceinline__ void gm_unit_naive(const bf16* Z, bf16* OC, int rowbase, int ntok, int g, const float* w_s, const float* b_s, const float* ln_g, const float* ln_b, float* gvn_out, float* sm, int tid) {
    const int lane = tid & 63, wave = tid >> 6;
    for (int i = wave; i < ntok; i += 8) { const size_t row = (size_t)(rowbase + i);
        const float x0 = bf2f(Z[row * BP + 2560 + g * 128 + lane]), x1 = bf2f(Z[row * BP + 2560 + g * 128 + lane + 64]);
        const float mu = wave_sum(x0 + x1) * (1.0f / 128.0f); const float d0 = x0 - mu, d1 = x1 - mu;
        const float var = wave_sum(d0 * d0 + d1 * d1) * (1.0f / 128.0f); const float rs = 1.0f / sqrtf(var + 1e-5f);
        const float y0 = d0 * rs * ln_g[g * 128 + lane] + ln_b[g * 128 + lane], y1 = d1 * rs * ln_g[g * 128 + lane + 64] + ln_b[g * 128 + lane + 64];
        sm[i * 128 + lane] = y0; sm[i * 128 + lane + 64] = y1;
        if (gvn_out) { gvn_out[i * 512 + g * 128 + lane] = y0; gvn_out[i * 512 + g * 128 + lane + 64] = y1; } }
    __syncthreads();
    const int d = tid & 127, iq = tid >> 7;
    for (int i = iq; i < ntok; i += 4) { float a = b_s[g * 128 + i]; const float* wr = w_s + (size_t)(g * 128 + i) * 128;
        for (int j = 0; j <= i; ++j) a = fmaf(wr[j], sm[j * 128 + d], a);
        const size_t row = (size_t)(rowbase + i); const float uu = bf2f(Z[row * BP + 2048 + g * 128 + d]);
        OC[row * BP + 512 + g * 128 + d] = (bf16)f2bf(uu * a); }
    __syncthreads();
}

__device__ __forceinline__ void sample_unit(const bf16* Z, bf16* OC, int db, int h, const float* S_in, float* S_out, float* gvn_out, const float* w_s, const float* b_s, const float* ln_g, const float* ln_b, float* sm, int tid) {
    const int dv = tid & 127, dq = tid >> 7, lane = tid & 63, wave = tid >> 6; const size_t row0 = (size_t)MP + (size_t)db * 8;
    float S[32];
#pragma unroll
    for (int kk = 0; kk < 32; ++kk) S[kk] = S_in[(dq * 32 + kk) * 128 + dv];
    v4u pc = (v4u){0u, 0u, 0u, 0u};
    if (tid < 384) { const int arr = tid >> 7, rem = tid & 127, tt = rem >> 4, ch = rem & 15; pc = *(const v4u*)(Z + (row0 + tt) * BP + arr * 512 + h * 128 + ch * 8); }
    const bf16* zr = Z + (row0 + wave) * BP + h * 128;
    const float g0 = bf2f(zr[1536 + lane]), g1 = bf2f(zr[1536 + lane + 64]), x0 = bf2f(zr[2560 + lane]), x1 = bf2f(zr[2560 + lane + 64]);
    const float lg0 = ln_g[h * 128 + lane], lg1 = ln_g[h * 128 + lane + 64], lb0 = ln_b[h * 128 + lane], lb1 = ln_b[h * 128 + lane + 64];
    const int dd = tid & 127, iq = tid >> 7;
    const float u0 = bf2f(Z[(row0 + iq) * BP + 2048 + h * 128 + dd]), u1 = bf2f(Z[(row0 + iq + 4) * BP + 2048 + h * 128 + dd]);
    float* sq = sm; float* red = sm + 3072; float* vn = sm + 3072 + 4096;
    if (tid < 384) { float* dst = sm + tid * 8;
        dst[0] = __uint_as_float(pc.x << 16); dst[1] = __uint_as_float(pc.x & 0xffff0000u); dst[2] = __uint_as_float(pc.y << 16); dst[3] = __uint_as_float(pc.y & 0xffff0000u);
        dst[4] = __uint_as_float(pc.z << 16); dst[5] = __uint_as_float(pc.z & 0xffff0000u); dst[6] = __uint_as_float(pc.w << 16); dst[7] = __uint_as_float(pc.w & 0xffff0000u); }
    { const float mu = wave_sum(x0 + x1) * (1.0f / 128.0f); const float d0 = x0 - mu, d1 = x1 - mu;
      const float var = wave_sum(d0 * d0 + d1 * d1) * (1.0f / 128.0f); const float rs = 1.0f / sqrtf(var + 1e-5f);
      const float y0 = d0 * rs * lg0 + lb0, y1 = d1 * rs * lg1 + lb1;
      vn[wave * 128 + lane] = y0; vn[wave * 128 + lane + 64] = y1;
      gvn_out[wave * 512 + h * 128 + lane] = y0; gvn_out[wave * 512 + h * 128 + lane + 64] = y1; }
    __syncthreads();
    const float* sk = sm + 1024; const float* sv = sm + 2048;
#pragma unroll 1
    for (int tt = 0; tt < 8; ++tt) {
        const float vv = sv[tt * 128 + dv]; float a = 0.f;
#pragma unroll
        for (int kk = 0; kk < 32; ++kk) { S[kk] = fmaf(sk[tt * 128 + dq * 32 + kk], vv, S[kk]); a = fmaf(sq[tt * 128 + dq * 32 + kk], S[kk], a); }
        red[(tt * 4 + dq) * 128 + dv] = a;
    }
    { const float l2g = h == 0 ? -0.04580368961312479f : h == 1 ? -0.02272007650008353f : h == 2 ? -0.011315313227834146f : -0.005646563141142063f; const float gC = exp2f(8.0f * l2g);
#pragma unroll
      for (int kk = 0; kk < 32; ++kk) S_out[(dq * 32 + kk) * 128 + dv] = S[kk] * gC; }
    { float a0 = b_s[h * 128 + iq], a1 = b_s[h * 128 + iq + 4]; const float* w0 = w_s + (size_t)(h * 128 + iq) * 128; const float* w1 = w0 + 4 * 128;
#pragma unroll
      for (int j = 0; j < 8; ++j) { const float vj = vn[j * 128 + dd]; if (j <= iq) a0 = fmaf(w0[j], vj, a0); if (j <= iq + 4) a1 = fmaf(w1[j], vj, a1); }
      OC[(row0 + iq) * BP + 512 + h * 128 + dd] = (bf16)f2bf(u0 * a0); OC[(row0 + iq + 4) * BP + 512 + h * 128 + dd] = (bf16)f2bf(u1 * a1); }
    __syncthreads();
    { const int tt = wave; float o0 = 0.f, o1 = 0.f;
#pragma unroll
      for (int q4 = 0; q4 < 4; ++q4) { o0 += red[(tt * 4 + q4) * 128 + lane]; o1 += red[(tt * 4 + q4) * 128 + lane + 64]; }
      const float ss = wave_sum(o0 * o0 + o1 * o1); const float rs = 1.0f / sqrtf(ss * (1.0f / 128.0f) + 1e-6f);
      OC[(row0 + tt) * BP + h * 128 + lane] = (bf16)f2bf(o0 * rs * g0); OC[(row0 + tt) * BP + h * 128 + lane + 64] = (bf16)f2bf(o1 * rs * g1); }
    __syncthreads();
}

typedef short v4i16_t __attribute__((ext_vector_type(4)));
typedef unsigned u32x2_t __attribute__((ext_vector_type(2)));
#define MFMA16(a, b, c) __builtin_amdgcn_mfma_f32_16x16x32_bf16((a), (b), (c), 0, 0, 0)
__device__ __forceinline__ v4i16_t trrd(LAS unsigned char* p) { return __builtin_amdgcn_ds_read_tr16_b64_v4i16((LAS v4i16_t*)p); }
__device__ __forceinline__ bf16x8 cat4(v4i16_t a, v4i16_t b) { return (bf16x8){a[0], a[1], a[2], a[3], b[0], b[1], b[2], b[3]}; }
__device__ __forceinline__ unsigned pkb(float lo, float hi) { return pg8::pkbf(lo, hi); }
__device__ __forceinline__ bf16x8 pack8(f32x4 a, f32x4 b) { v4u w; w.x = pkb(a[0], a[1]); w.y = pkb(a[2], a[3]); w.z = pkb(b[0], b[1]); w.w = pkb(b[2], b[3]); return __builtin_bit_cast(bf16x8, w); }
__device__ __forceinline__ f32x4 unpk4(u32x2_t w) { return (f32x4){__uint_as_float(w.x << 16), __uint_as_float(w.x & 0xffff0000u), __uint_as_float(w.y << 16), __uint_as_float(w.y & 0xffff0000u)}; }

constexpr int R_RS = 272, R_RSV = 288, R_QS = 0, R_KS = 128 * R_RS, R_ST = 2 * 128 * R_RS, R_VS = 3 * 128 * R_RS;
static_assert(R_VS + 128 * R_RSV <= SCR_BYTES, "retention LDS");
constexpr int RS_K = 0, RS_VH = 128 * R_RS, RS_VST = 144;
__device__ __forceinline__ void ret_state_unit(const bf16* Z, bf16* SIMG, float* S_out, int b, int h, int half, LAS unsigned char* L, int tid) {
    const int lane = tid & 63, w = __builtin_amdgcn_readfirstlane(tid >> 6), c = lane & 15, g = lane >> 4, q = c >> 2, p = c & 3;
    const float l2g = h == 0 ? -0.04580368961312479f : h == 1 ? -0.02272007650008353f : h == 2 ? -0.011315313227834146f : -0.005646563141142063f;
    const float gC = exp2f(128.0f * l2g);
    f32x4 st[4];
#pragma unroll
    for (int i = 0; i < 4; ++i) st[i] = (f32x4){0.f, 0.f, 0.f, 0.f};
    const bf16* zb = Z + (size_t)b * SEQ * BP + h * 128;
    v4u rk[4], rv[2];
#pragma unroll
    for (int i = 0; i < 4; ++i) { const int idx = tid + 512 * i; rk[i] = *(const v4u*)(zb + (size_t)(idx >> 4) * BP + 512 + (idx & 15) * 8); }
#pragma unroll
    for (int i = 0; i < 2; ++i) { const int idx = tid + 512 * i; rv[i] = *(const v4u*)(zb + (size_t)(idx >> 3) * BP + 1024 + half * 64 + (idx & 7) * 8); }
#pragma unroll 1
    for (int n = 0; n < 16; ++n) {
#pragma unroll
        for (int i = 0; i < 4; ++i) { const int idx = tid + 512 * i; *(LAS v4u*)(L + RS_K + (idx >> 4) * R_RS + (idx & 15) * 16) = rk[i]; }
#pragma unroll
        for (int i = 0; i < 2; ++i) { const int idx = tid + 512 * i; *(LAS v4u*)(L + RS_VH + (idx >> 3) * RS_VST + (idx & 7) * 16) = rv[i]; }
        __syncthreads();
        if (n < 15) { const bf16* zn = zb + (size_t)(n + 1) * 128 * BP;
#pragma unroll
            for (int i = 0; i < 4; ++i) { const int idx = tid + 512 * i; rk[i] = *(const v4u*)(zn + (size_t)(idx >> 4) * BP + 512 + (idx & 15) * 8); }
#pragma unroll
            for (int i = 0; i < 2; ++i) { const int idx = tid + 512 * i; rv[i] = *(const v4u*)(zn + (size_t)(idx >> 3) * BP + 1024 + half * 64 + (idx & 7) * 8); } }
        { bf16x8 Ak[4];
#pragma unroll
          for (int s = 0; s < 4; ++s) Ak[s] = cat4(trrd(L + RS_K + (32 * s + 8 * g + q) * R_RS + (16 * w + 4 * p) * 2), trrd(L + RS_K + (32 * s + 8 * g + 4 + q) * R_RS + (16 * w + 4 * p) * 2));
#pragma unroll
          for (int dt = 0; dt < 4; ++dt) {
#pragma unroll
              for (int s = 0; s < 4; ++s) { const bf16x8 Bv = cat4(trrd(L + RS_VH + (32 * s + 8 * g + q) * RS_VST + (16 * dt + 4 * p) * 2), trrd(L + RS_VH + (32 * s + 8 * g + 4 + q) * RS_VST + (16 * dt + 4 * p) * 2));
                  st[dt] = MFMA16(Ak[s], Bv, st[dt]); }
              st[dt] = st[dt] * gC; } }
        if (n < 15) { bf16* img = SIMG + ((size_t)((b * 4 + h) * 16 + n + 1)) * 16384 + (size_t)(64 * half + c) * 128 + 16 * w + 4 * g;
#pragma unroll
            for (int dt = 0; dt < 4; ++dt) { u32x2_t wv; wv.x = pkb(st[dt][0], st[dt][1]); wv.y = pkb(st[dt][2], st[dt][3]); *(u32x2_t*)(img + (size_t)(16 * dt) * 128) = wv; } }
        __syncthreads();
    }
#pragma unroll
    for (int dt = 0; dt < 4; ++dt)
#pragma unroll
        for (int e = 0; e < 4; ++e) S_out[(16 * w + 4 * g + e) * 128 + 64 * half + 16 * dt + c] = st[dt][e];
}
__device__ __forceinline__ void ret_out_phase(const bf16* Z, bf16* OC, const bf16* SIMG, int b0, int nb, int rk, int nl, LAS unsigned char* L, int tid) {
    const int lane = tid & 63, w = __builtin_amdgcn_readfirstlane(tid >> 6), c = lane & 15, g = lane >> 4, q = c >> 2, p = c & 3;
    const int total = 64 * nb; if (rk >= total) return;
    v4u pq[4], pk[4], pv[4], ps[4];
#define RO_LOAD(u_) do { const int b_ = b0 + ((u_) >> 6), n_ = ((u_) >> 2) & 15, h_ = (u_) & 3; const size_t r_ = (size_t)b_ * SEQ + (size_t)n_ * 128; const bf16* sg_ = SIMG + ((size_t)((b_ * 4 + h_) * 16 + n_)) * 16384; \
        _Pragma("unroll") for (int i = 0; i < 4; ++i) { const int idx = tid + 512 * i, row = idx >> 4, ch = idx & 15; const bf16* src = Z + (r_ + row) * BP + h_ * 128 + ch * 8; \
            pq[i] = *(const v4u*)src; pk[i] = *(const v4u*)(src + 512); pv[i] = *(const v4u*)(src + 1024); ps[i] = *(const v4u*)(sg_ + row * 128 + ch * 8); } } while (0)
    RO_LOAD(rk);
#pragma unroll 1
    for (int uid = rk; uid < total; uid += nl) {
    const int b = b0 + (uid >> 6), n = (uid >> 2) & 15, h = uid & 3;
    const size_t r0 = (size_t)b * SEQ + (size_t)n * 128;
#pragma unroll
    for (int i = 0; i < 4; ++i) { const int idx = tid + 512 * i, row = idx >> 4, ch = idx & 15;
        *(LAS v4u*)(L + R_QS + row * R_RS + ch * 16) = pq[i]; *(LAS v4u*)(L + R_KS + row * R_RS + ch * 16) = pk[i]; *(LAS v4u*)(L + R_VS + row * R_RSV + ch * 16) = pv[i]; *(LAS v4u*)(L + R_ST + row * R_RS + ch * 16) = ps[i]; }
    __syncthreads();
    { const int un = uid + nl < total ? uid + nl : uid; RO_LOAD(un); }
    u32x2_t gv8[8];
    { const bf16* gp0 = Z + (r0 + 16 * w + c) * BP + 1536 + h * 128 + 4 * g;
#pragma unroll
      for (int dt = 0; dt < 8; ++dt) gv8[dt] = *(const u32x2_t*)(gp0 + 16 * dt); }
    bf16x8 Bq[4];
#pragma unroll
    for (int s = 0; s < 4; ++s) Bq[s] = *(const LAS bf16x8*)(L + R_QS + (16 * w + c) * R_RS + (32 * s + 8 * g) * 2);
    f32x4 pt[8];
#pragma unroll
    for (int jt = 0; jt < 8; ++jt) { f32x4 a = (f32x4){0.f, 0.f, 0.f, 0.f};
        if (jt <= w) {
#pragma unroll
            for (int s = 0; s < 4; ++s) { const bf16x8 A = *(const LAS bf16x8*)(L + R_KS + (16 * jt + c) * R_RS + (32 * s + 8 * g) * 2); a = MFMA16(A, Bq[s], a); }
            if (jt == w) {
#pragma unroll
                for (int e = 0; e < 4; ++e) if (4 * g + e > c) a[e] = 0.f; }
        }
        pt[jt] = a; }
    bf16x8 bfr[4];
#pragma unroll
    for (int s = 0; s < 4; ++s) bfr[s] = pack8(pt[2 * s], pt[2 * s + 1]);
    f32x4 ot[8];
#pragma unroll
    for (int dt = 0; dt < 8; ++dt) { f32x4 a = (f32x4){0.f, 0.f, 0.f, 0.f};
        if (n > 0) {
#pragma unroll
            for (int s = 0; s < 4; ++s) { const bf16x8 A = *(const LAS bf16x8*)(L + R_ST + (16 * dt + c) * R_RS + (32 * s + 8 * g) * 2); a = MFMA16(A, Bq[s], a); } }
#pragma unroll
        for (int s = 0; s < 4; ++s) if (2 * s <= w) {
            const v4i16_t a0 = trrd(L + R_VS + (32 * s + 4 * g + q) * R_RSV + (16 * dt + 4 * p) * 2), a1 = trrd(L + R_VS + (32 * s + 16 + 4 * g + q) * R_RSV + (16 * dt + 4 * p) * 2);
            a = MFMA16(cat4(a0, a1), bfr[s], a); }
        ot[dt] = a; }
    { float ss = 0.f;
#pragma unroll
      for (int dt = 0; dt < 8; ++dt) ss += (ot[dt][0] * ot[dt][0] + ot[dt][1] * ot[dt][1]) + (ot[dt][2] * ot[dt][2] + ot[dt][3] * ot[dt][3]);
      ss += __shfl_xor(ss, 16); ss += __shfl_xor(ss, 32);
      const float rs = 1.0f / sqrtf(ss * (1.0f / 128.0f) + 1e-6f);
      const size_t row = r0 + 16 * w + c; bf16* op = OC + row * BP + h * 128 + 4 * g;
#pragma unroll
      for (int dt = 0; dt < 8; ++dt) { const f32x4 gg = unpk4(gv8[dt]); const f32x4 o = ot[dt] * rs * gg;
          u32x2_t wv; wv.x = pkb(o[0], o[1]); wv.y = pkb(o[2], o[3]); *(u32x2_t*)(op + 16 * dt) = wv; } }
    __syncthreads();
    }
#undef RO_LOAD
}
__device__ __forceinline__ void gm_unit_mfma(const bf16* Z, bf16* OC, const bf16* Wb, const float* b_s, const float* ln_g, const float* ln_b, size_t r0, int g, LAS unsigned char* L, int tid) {
    const int lane = tid & 63, w = __builtin_amdgcn_readfirstlane(tid >> 6), c = lane & 15, g4 = lane >> 4, q = c >> 2, p = c & 3;
    u32x2_t uv[8];
    { const bf16* up0 = Z + (r0 + 16 * w + c) * BP + 2048 + g * 128 + 4 * g4;
#pragma unroll
      for (int dt = 0; dt < 8; ++dt) uv[dt] = *(const u32x2_t*)(up0 + 16 * dt); }
    {
      const bf16* zb = Z + r0 * BP + 2560 + g * 128;
      v4u pv[4];
#pragma unroll
      for (int i = 0; i < 4; ++i) { const int idx = tid + 512 * i; pv[i] = *(const v4u*)(zb + (size_t)(idx >> 4) * BP + (idx & 15) * 8); }
      const int ch = tid & 15;
      const f32x4 lg0 = *(const f32x4*)(ln_g + g * 128 + ch * 8), lg1 = *(const f32x4*)(ln_g + g * 128 + ch * 8 + 4), lb0 = *(const f32x4*)(ln_b + g * 128 + ch * 8), lb1 = *(const f32x4*)(ln_b + g * 128 + ch * 8 + 4);
#pragma unroll
      for (int i = 0; i < 4; ++i) { const int row = (tid + 512 * i) >> 4;
          u32x2_t lo2, hi2; lo2.x = pv[i].x; lo2.y = pv[i].y; hi2.x = pv[i].z; hi2.y = pv[i].w;
          const f32x4 x0 = unpk4(lo2), x1 = unpk4(hi2);
          float s = (x0[0] + x0[1]) + (x0[2] + x0[3]) + (x1[0] + x1[1]) + (x1[2] + x1[3]);
          s += __shfl_xor(s, 1); s += __shfl_xor(s, 2); s += __shfl_xor(s, 4); s += __shfl_xor(s, 8);
          const float mu = s * (1.0f / 128.0f); const f32x4 d0 = x0 - mu, d1 = x1 - mu;
          float v = (d0[0] * d0[0] + d0[1] * d0[1]) + (d0[2] * d0[2] + d0[3] * d0[3]) + (d1[0] * d1[0] + d1[1] * d1[1]) + (d1[2] * d1[2] + d1[3] * d1[3]);
          v += __shfl_xor(v, 1); v += __shfl_xor(v, 2); v += __shfl_xor(v, 4); v += __shfl_xor(v, 8);
          const float rs = 1.0f / sqrtf(v * (1.0f / 128.0f) + 1e-5f);
          const f32x4 y0 = d0 * rs * lg0 + lb0, y1 = d1 * rs * lg1 + lb1;
          v4u wv; wv.x = pkb(y0[0], y0[1]); wv.y = pkb(y0[2], y0[3]); wv.z = pkb(y1[0], y1[1]); wv.w = pkb(y1[2], y1[3]);
          *(LAS v4u*)(L + row * R_RSV + ch * 16) = wv; } }
    __syncthreads();
    f32x4 mt[8];
#pragma unroll
    for (int i = 0; i < 8; ++i) mt[i] = (f32x4){0.f, 0.f, 0.f, 0.f};
    bf16x8 Bw4[4];
#pragma unroll
    for (int s = 0; s < 4; ++s) Bw4[s] = *(const bf16x8*)(Wb + (size_t)(g * 128 + 16 * w + c) * 128 + 32 * s + 8 * g4);
#pragma unroll
    for (int s = 0; s < 4; ++s) if (2 * s <= w) {
        const bf16x8 Bw = Bw4[s];
#pragma unroll
        for (int dt = 0; dt < 8; ++dt) { const bf16x8 A = cat4(trrd(L + (32 * s + 8 * g4 + q) * R_RSV + (16 * dt + 4 * p) * 2), trrd(L + (32 * s + 8 * g4 + 4 + q) * R_RSV + (16 * dt + 4 * p) * 2)); mt[dt] = MFMA16(A, Bw, mt[dt]); } }
    { const size_t row = r0 + 16 * w + c; const float bias = b_s[g * 128 + 16 * w + c]; bf16* op = OC + row * BP + 512 + g * 128 + 4 * g4;
#pragma unroll
      for (int dt = 0; dt < 8; ++dt) { const f32x4 uu = unpk4(uv[dt]); const f32x4 o = uu * (mt[dt] + bias);
          u32x2_t wv; wv.x = pkb(o[0], o[1]); wv.y = pkb(o[2], o[3]); *(u32x2_t*)(op + 16 * dt) = wv; } }
    __syncthreads();
}
constexpr int A_KST = 144, A_K = 0, A_V = 256 * A_KST;
template <bool FAST>
__device__ __forceinline__ void attn_tile_mfma(const bf16x8 Bq0, const bf16x8 Bq1, bf16* orow, int irel, float sink2, int sg0, int jmin, int odd, LAS unsigned char* L, int lane) {
    const int c = lane & 15, g = lane >> 4, q = c >> 2, p = c & 3;
    bf16x8 Bq[2]; Bq[0] = Bq0; Bq[1] = Bq1;
    f32x4 pt[10]; float m = sink2;
#pragma unroll
    for (int t = 0; t < 10; ++t) { const int kt = 2 * sg0 + t; f32x4 a = (f32x4){0.f, 0.f, 0.f, 0.f};
        const bool dead = FAST && (t < odd || t > 8 + odd);
        if (!dead) {
#pragma unroll
            for (int s = 0; s < 2; ++s) { const bf16x8 A = *(const LAS bf16x8*)(L + A_K + (16 * kt + c) * A_KST + (32 * s + 8 * g) * 2); a = MFMA16(A, Bq[s], a); }
            if (FAST) {
                if (t == odd) {
#pragma unroll
                    for (int e = 0; e < 4; ++e) if (4 * g + e < c) a[e] = -INFINITY; }
                else if (t == 8 + odd) {
#pragma unroll
                    for (int e = 0; e < 4; ++e) if (4 * g + e > c) a[e] = -INFINITY; }
            } else {
#pragma unroll
                for (int e = 0; e < 4; ++e) { const int j = 16 * kt + 4 * g + e; if (j < irel || j > irel + 128 || j < jmin) a[e] = -INFINITY; }
            }
            m = fmaxf(fmaxf(m, fmaxf(a[0], a[1])), fmaxf(a[2], a[3]));
        } else a = (f32x4){-INFINITY, -INFINITY, -INFINITY, -INFINITY};
        pt[t] = a; }
    m = fmaxf(m, __shfl_xor(m, 16)); m = fmaxf(m, __shfl_xor(m, 32));
    float l = 0.f;
#pragma unroll
    for (int t = 0; t < 10; ++t)
#pragma unroll
        for (int e = 0; e < 4; ++e) { const float pe = __builtin_amdgcn_exp2f(pt[t][e] - m); pt[t][e] = pe; l += pe; }
    l += __shfl_xor(l, 16); l += __shfl_xor(l, 32); l += __builtin_amdgcn_exp2f(sink2 - m);
    f32x4 ot[4];
#pragma unroll
    for (int dt = 0; dt < 4; ++dt) ot[dt] = (f32x4){0.f, 0.f, 0.f, 0.f};
#pragma unroll
    for (int s = 0; s < 5; ++s) { const bf16x8 bf = pack8(pt[2 * s], pt[2 * s + 1]); const int R0 = 32 * (sg0 + s) + 4 * g + q;
#pragma unroll
        for (int dt = 0; dt < 4; ++dt) { const v4i16_t a0 = trrd(L + A_V + R0 * A_KST + (16 * dt + 4 * p) * 2), a1 = trrd(L + A_V + (R0 + 16) * A_KST + (16 * dt + 4 * p) * 2); ot[dt] = MFMA16(cat4(a0, a1), bf, ot[dt]); } }
    const float inv = 1.0f / l;
#pragma unroll
    for (int dt = 0; dt < 4; ++dt) { const f32x4 o = ot[dt] * inv; u32x2_t wv; wv.x = pkb(o[0], o[1]); wv.y = pkb(o[2], o[3]); *(u32x2_t*)(orow + 16 * dt + 4 * g) = wv; }
}
#ifndef SG_NTB
#define SG_NTB 0
#endif
constexpr int SG_BK = 256, SG_RS = SG_BK * 2, SG_OP = 64 * SG_RS, SG_BUF = 2 * SG_OP;
static_assert(2 * SG_BUF <= SCR_BYTES, "sample GEMM LDS");
template <class Epi> __device__ __forceinline__ void sgemm_phase(LAS unsigned char* L, const bf16* A, const bf16* Bt, int N, int K, const Epi& E, int lda, int tm0, int ntm, int vid, int nv, int it0, int it1, int tid_in) {
    int tid = tid_in; asm volatile("" : "+v"(tid));
    const int lane = tid & 63, w = __builtin_amdgcn_readfirstlane(tid >> 6), c = lane & 15, g = lane >> 4, srow = tid >> 5, sch = tid & 31, tq = w & 3, nh = w >> 2;
    const int nk = K / SG_BK, total = ntm * (N / 64);
    const unsigned a_row = (unsigned)((16 * tq + c) * SG_RS), w_row0 = (unsigned)(SG_OP + (32 * nh + 8 * (c >> 2) + (c & 3)) * SG_RS), w_row1 = w_row0 + 4 * SG_RS;
    unsigned st_a[4], st_b[4];
#pragma unroll
    for (int i = 0; i < 4; ++i) { const int r = srow + 16 * i; st_a[i] = (unsigned)(r * SG_RS + 16 * (sch ^ (r & 15))); st_b[i] = (unsigned)(SG_OP + r * SG_RS + 16 * (sch ^ (4 * ((r >> 3) & 3) + (r & 3)))); }
    int nun = 0; { const int first = vid + it0 * nv; if (first < total && it1 > it0) { nun = (total - 1 - first) / nv + 1; if (nun > it1 - it0) nun = it1 - it0; } }
    if (nun <= 0) return;
    const int lnk = nk == 4 ? 2 : 4, S = nun * nk;
    f32x4 acc0 = (f32x4){0.f, 0.f, 0.f, 0.f}, acc1 = acc0;
    v4u xa[4], xb[4], ya[4], yb[4];
#define SG_LOAD(RA, RB, s_) do { const int sc_ = (s_) < S ? (s_) : S - 1, j_ = sc_ >> lnk, kt_ = sc_ - (j_ << lnk), ux_ = vid + (it0 + j_) * nv, tn_ = ux_ / ntm, tm_ = tm0 + ux_ % ntm; \
        const bf16* ga = A + (size_t)(64 * tm_ + srow) * lda + sch * 8 + kt_ * SG_BK; const bf16* gb = Bt + (size_t)(64 * tn_ + srow) * K + sch * 8 + kt_ * SG_BK; \
        _Pragma("unroll") for (int i = 0; i < 4; ++i) { RA[i] = *(const v4u*)(ga + (size_t)(16 * i) * lda); RB[i] = SG_NTB ? __builtin_nontemporal_load((const v4u*)(gb + (size_t)(16 * i) * K)) : *(const v4u*)(gb + (size_t)(16 * i) * K); } } while (0)
#define SG_STORE(RA, RB, off) do { _Pragma("unroll") for (int i = 0; i < 4; ++i) { *(LAS v4u*)(L + (off) + st_a[i]) = RA[i]; *(LAS v4u*)(L + (off) + st_b[i]) = RB[i]; } } while (0)
#define SG_COMPUTE(off) do { _Pragma("unroll") for (int ks = 0; ks < SG_BK / 32; ++ks) { const unsigned po = 16u * (unsigned)((4 * ks + g) ^ c); \
            const bf16x8 T = *(const LAS bf16x8*)(L + (off) + a_row + po), W0 = *(const LAS bf16x8*)(L + (off) + w_row0 + po), W1 = *(const LAS bf16x8*)(L + (off) + w_row1 + po); \
            acc0 = MFMA16(W0, T, acc0); acc1 = MFMA16(W1, T, acc1); } } while (0)
    SG_LOAD(ya, yb, 0); SG_STORE(ya, yb, 0);
    SG_LOAD(xa, xb, 1);
    __syncthreads();
#pragma unroll 1
    for (int s = 0; s < S; s += 2) {
        float pre_r; pg8::u32x4 hw_r;
        { const int j0 = s >> lnk, u0 = vid + (it0 + j0) * nv, tn0 = u0 / ntm, tm0_ = tm0 + u0 % ntm, r0 = MP + 64 * tm0_ + 16 * tq + c, col0 = 64 * tn0 + 32 * nh + 8 * g;
          pre_r = E.rowpre(r0); hw_r = E.hpre(r0, col0); }
        SG_LOAD(ya, yb, s + 2);
        if ((s & (nk - 1)) == 0) { acc0 = (f32x4){0.f, 0.f, 0.f, 0.f}; acc1 = acc0; }
        SG_COMPUTE(0);
        SG_STORE(xa, xb, SG_BUF);
        __syncthreads();
        SG_LOAD(xa, xb, s + 3);
        SG_COMPUTE(SG_BUF);
        if (((s + 1) & (nk - 1)) == nk - 1) {
            const int j = (s + 1) >> lnk, uidx = vid + (it0 + j) * nv, tn = uidx / ntm, tm = tm0 + uidx % ntm;
            const int r = MP + 64 * tm + 16 * tq + c, col = 64 * tn + 32 * nh + 8 * g;
            float ss = E.apply_p(r, col, acc0, acc1, pre_r, hw_r);
            if (Epi::HAS_POST) { ss += __shfl_xor(ss, 16); ss += __shfl_xor(ss, 32); E.post(r, ss, g == 0); } }
        SG_STORE(ya, yb, 0);
        __syncthreads();
    }
#undef SG_LOAD
#undef SG_STORE
#undef SG_COMPUTE
}
constexpr int S8_BK = 128, S8_RS = S8_BK * 2, S8_OP = 128 * S8_RS, S8_BUF = 2 * S8_OP;
static_assert(2 * S8_BUF <= SCR_BYTES, "128x128 sample GEMM LDS");
template <class Epi> __device__ __forceinline__ void sgemm128_phase(LAS unsigned char* L, const bf16* A, const bf16* Bt, int N, int K, const Epi& E, int lda, int tm0, int vid, int nv, int it0, int it1, int tid_in) {
    int tid = tid_in; asm volatile("" : "+v"(tid));
    const int lane = tid & 63, w = __builtin_amdgcn_readfirstlane(tid >> 6), c = lane & 15, g = lane >> 4, srow = tid >> 4, sch = tid & 15, tq = w & 3, nh = w >> 2;
    const int nk = K / S8_BK, total = N / 128;
    const unsigned a_row = (unsigned)((32 * tq + c) * S8_RS), w_row = (unsigned)(S8_OP + (64 * nh + 8 * (c >> 2) + (c & 3)) * S8_RS);
    unsigned st_a[4], st_b[4];
#pragma unroll
    for (int i = 0; i < 4; ++i) { const int r = srow + 32 * i; st_a[i] = (unsigned)(r * S8_RS + 16 * (sch ^ (r & 15))); st_b[i] = (unsigned)(S8_OP + r * S8_RS + 16 * (sch ^ (4 * ((r >> 3) & 3) + (r & 3)))); }
    for (int it = it0; it < it1; ++it) {
        const int tn = vid + it * nv; if (tn >= total) break;
        const bf16* ga = A + (size_t)(64 * tm0 + srow) * lda + sch * 8; const bf16* gb = Bt + (size_t)(128 * tn + srow) * K + sch * 8;
        f32x4 acc[2][2][2];
#pragma unroll
        for (int i = 0; i < 8; ++i) acc[i >> 2][(i >> 1) & 1][i & 1] = (f32x4){0.f, 0.f, 0.f, 0.f};
        v4u xa[4], xb[4], ya[4], yb[4];
#define S8_LOAD(RA, RB, kk) do { _Pragma("unroll") for (int i = 0; i < 4; ++i) { RA[i] = *(const v4u*)(ga + (size_t)(32 * i) * lda + (kk) * S8_BK); RB[i] = *(const v4u*)(gb + (size_t)(32 * i) * K + (kk) * S8_BK); } } while (0)
#define S8_STORE(RA, RB, off) do { _Pragma("unroll") for (int i = 0; i < 4; ++i) { *(LAS v4u*)(L + (off) + st_a[i]) = RA[i]; *(LAS v4u*)(L + (off) + st_b[i]) = RB[i]; } } while (0)
#define S8_COMPUTE(off) do { _Pragma("unroll") for (int ks = 0; ks < S8_BK / 32; ++ks) { const unsigned po = 16u * (unsigned)((4 * ks + g) ^ c); \
            const bf16x8 T0 = *(const LAS bf16x8*)(L + (off) + a_row + po), T1 = *(const LAS bf16x8*)(L + (off) + a_row + 16 * S8_RS + po); \
            _Pragma("unroll") for (int t = 0; t < 4; ++t) { const bf16x8 W = *(const LAS bf16x8*)(L + (off) + w_row + (32 * (t >> 1) + 4 * (t & 1)) * S8_RS + po); \
                acc[0][t >> 1][t & 1] = MFMA16(W, T0, acc[0][t >> 1][t & 1]); acc[1][t >> 1][t & 1] = MFMA16(W, T1, acc[1][t >> 1][t & 1]); } } } while (0)
        S8_LOAD(ya, yb, 0); S8_STORE(ya, yb, 0);
        S8_LOAD(xa, xb, 1);
        __syncthreads();
#pragma unroll 1
        for (int kt = 0; kt < nk; kt += 2) {
            S8_LOAD(ya, yb, kt + 2 < nk ? kt + 2 : nk - 1);
            S8_COMPUTE(0);
            S8_STORE(xa, xb, S8_BUF);
            __syncthreads();
            S8_LOAD(xa, xb, kt + 3 < nk ? kt + 3 : nk - 1);
            S8_COMPUTE(S8_BUF);
            if (kt + 2 < nk) S8_STORE(ya, yb, 0);
            __syncthreads();
        }
#undef S8_LOAD
#undef S8_STORE
#undef S8_COMPUTE
#pragma unroll
        for (int ti = 0; ti < 2; ++ti) { const int r = MP + 64 * tm0 + 32 * tq + 16 * ti + c; const float pre = E.rowpre(r); float ss = 0.f;
#pragma unroll
            for (int pq = 0; pq < 2; ++pq) ss += E.apply(r, 128 * tn + 64 * nh + 32 * pq + 8 * g, acc[ti][pq][0], acc[ti][pq][1], pre);
            if (Epi::HAS_POST) { ss += __shfl_xor(ss, 16); ss += __shfl_xor(ss, 32); E.post(r, ss, g == 0); } }
    }
}

template <class Epi, int TM, int TN> __device__ __forceinline__ void sg3_phase(LAS unsigned char* L, const bf16* A, const bf16* Bt, int N, int K, const Epi& E, int lda, int tm0, int ntm, int vid, int nv, int it0, int it1, int tid_in) {
    static_assert((TM == 128 && TN == 128) || (TM == 64 && TN == 64), "tile");
    constexpr int ABYTES = TM * 128, SLOT = ABYTES + TN * 128, NS = TM == 128 ? 4 : 8, NI = TM / 64, P = 2 * NI, MT = TM / 64, NT = TN / 32;
    static_assert(NS * SLOT <= SCR_BYTES, "sample GEMM ring");
    int tid = tid_in; asm volatile("" : "+v"(tid));
    const int lane = tid & 63, w = __builtin_amdgcn_readfirstlane(tid >> 6), c = lane & 15, g = lane >> 4, wr = w >> 1, wc = w & 1;
    const int sb_ = lane * 16, swz = sb_ ^ (((sb_ >> 9) & 1) << 5), rr = swz >> 6, cc = (swz & 63) >> 1;
    const unsigned voA = (unsigned)(((w >> 1) * 16 + rr) * lda + (w & 1) * 32 + cc) * 2u;
    const unsigned voB = (unsigned)(((w >> 2) * 32 + pg8::perm32(16 * ((w >> 1) & 1) + rr)) * K + (w & 1) * 32 + cc) * 2u;
    const unsigned aoff = (unsigned)pg8::lds_byte((TM == 128 ? 32 : 16) * wr + c, 8 * g), boff = (unsigned)(ABYTES + pg8::lds_byte((TN / 2) * wc + c, 8 * g));
    const int nk = K >> 6, total = TM == 128 ? N / 128 : ntm * (N / 64);
#define SG3_WAIT(n) asm volatile("s_waitcnt vmcnt(%0)" :: "n"(n) : "memory")
    for (int it = it0; it < it1; ++it) {
        const int u = vid + it * nv; if (u >= total) break;
        const int tn = TM == 128 ? u : u / ntm, tm = TM == 128 ? tm0 : tm0 + u % ntm;
        const char* pa = (const char*)(A + (size_t)(64 * tm) * lda); const char* pb = (const char*)(Bt + (size_t)(TN * tn) * K);
        const int rbase = MP + 64 * tm + (TM == 128 ? 32 : 16) * wr + c;
        float pre[MT];
#pragma unroll
        for (int m = 0; m < MT; ++m) pre[m] = E.rowpre(rbase + 16 * m);
        f32x4 acc[MT][NT];
#pragma unroll
        for (int m = 0; m < MT; ++m)
#pragma unroll
            for (int n = 0; n < NT; ++n) acc[m][n] = (f32x4){0.f, 0.f, 0.f, 0.f};
#define SG3_ISSUE(kk, slot) do { const char* qa_ = pa + (size_t)(kk) * 128; const char* qb_ = pb + (size_t)(kk) * 128; LAS unsigned char* ld_ = L + (slot) * SLOT + w * 1024; \
        _Pragma("unroll") for (int i_ = 0; i_ < NI; ++i_) { \
            __builtin_amdgcn_global_load_lds((const unsigned*)(qa_ + (size_t)i_ * 128 * lda + voA), (LAS unsigned*)(ld_ + i_ * 8192), 16, 0, 0); \
            __builtin_amdgcn_global_load_lds((const unsigned*)(qb_ + (size_t)i_ * 128 * K + voB), (LAS unsigned*)(ld_ + ABYTES + i_ * 8192), 16, 0, 0); } } while (0)
#pragma unroll
        for (int s0 = 0; s0 < NS - 1; ++s0) SG3_ISSUE(s0, s0);
        int slot = 0, nslot = NS - 1;
#define SG3_BAR() do { __builtin_amdgcn_s_barrier(); asm volatile("" ::: "memory"); __builtin_amdgcn_sched_barrier(0); } while (0)
#define SG3_COMPUTE() do { const unsigned so = (unsigned)(slot * SLOT); bf16x8 T[MT][2], W[NT][2]; \
            _Pragma("unroll") for (int m = 0; m < MT; ++m) _Pragma("unroll") for (int kk = 0; kk < 2; ++kk) T[m][kk] = *(const LAS bf16x8*)(L + so + aoff + m * 2048 + kk * 1024); \
            _Pragma("unroll") for (int n = 0; n < NT; ++n) _Pragma("unroll") for (int kk = 0; kk < 2; ++kk) W[n][kk] = *(const LAS bf16x8*)(L + so + boff + n * 2048 + kk * 1024); \
            _Pragma("unroll") for (int kk = 0; kk < 2; ++kk) _Pragma("unroll") for (int m = 0; m < MT; ++m) _Pragma("unroll") for (int n = 0; n < NT; ++n) acc[m][n] = MFMA16(W[n][kk], T[m][kk], acc[m][n]); \
            slot = slot + 1 == NS ? 0 : slot + 1; } while (0)
#pragma unroll 1
        for (int k = 0; k + NS - 1 < nk; ++k) {
            SG3_WAIT((NS - 2) * P); SG3_BAR();
            SG3_ISSUE(k + NS - 1, nslot); nslot = nslot + 1 == NS ? 0 : nslot + 1;
            SG3_COMPUTE();
        }
#define SG3_TAIL(j) if constexpr (NS - 2 >= (j)) { SG3_WAIT((j) * P); SG3_BAR(); SG3_COMPUTE(); }
        SG3_TAIL(6) SG3_TAIL(5) SG3_TAIL(4) SG3_TAIL(3) SG3_TAIL(2) SG3_TAIL(1) SG3_TAIL(0)
#undef SG3_TAIL
#undef SG3_COMPUTE
#undef SG3_ISSUE
        asm volatile("s_waitcnt lgkmcnt(0)" ::: "memory"); SG3_BAR();
#undef SG3_BAR
#pragma unroll
        for (int m = 0; m < MT; ++m) { const int r = rbase + 16 * m; float ss = 0.f;
#pragma unroll
            for (int pq = 0; pq < NT / 2; ++pq) ss += E.apply(r, TN * tn + (TN / 2) * wc + 32 * pq + 8 * g, acc[m][2 * pq], acc[m][2 * pq + 1], pre[m]);
            if (Epi::HAS_POST) { ss += __shfl_xor(ss, 16); ss += __shfl_xor(ss, 32); E.post(r, ss, g == 0); } }
    }
#undef SG3_WAIT
    __syncthreads();
}

#ifndef NSUB
#define NSUB 1u
#endif
#ifndef SG3_MINN
#define SG3_MINN 4096
#endif
#ifndef SG3_WIDE
#define SG3_WIDE 0
#endif
#ifndef P2MIX
#define P2MIX 0
#endif
#ifndef P2MIX_SH
#define P2MIX_SH 0
#endif
#ifndef FINE128
#define FINE128 1
#endif
#ifndef FUSE_FIN
#define FUSE_FIN 1
#endif
#ifndef P2_KS
#define P2_KS 3
#endif
#ifndef STG_NFIRST
#define STG_NFIRST(rk, nfine) ((STAGGER && ((rk) & 1)) ? (nfine) : 0)
#endif
#ifndef STAGGER
#define STAGGER 1
#endif
#ifndef SKEW_TICKS
#define SKEW_TICKS 0
#endif
struct Args { const float* in[21]; float* out; unsigned char* ws; };
__global__ void __launch_bounds__(NWAVES * 64, 2) fwd_kernel(Args args) {
    extern __shared__ __attribute__((aligned(16))) unsigned char lds[];
    LAS unsigned char* const L = (LAS unsigned char*)lds;
    volatile LAS unsigned* const MISC = (volatile LAS unsigned*)(L + MISC_OFF);
    const int G = gridDim.x, bx = blockIdx.x, vcu = (G % 8 == 0) ? (bx % 8) * (G / 8) + bx / 8 : bx;
    unsigned char* const ws = args.ws; float* const out = args.out;
    gu32* const ctl = (gu32*)(ws + WS_CTL);
    for (int u = threadIdx.x; u < (LDS_BYTES - LDSCTL_OFF) / 4; u += NWAVES * 64) ((LAS unsigned*)(L + LDSCTL_OFF))[u] = 0u;
    __syncthreads();
    const XcdBarrier bar = xcd_barrier_post((unsigned*)(ctl + CW_BAR), MISC + 8);
    float* const sm = (float*)lds;
    int tid_k = threadIdx.x;
#define INP(i) (args.in[i])
#define WSP(T, off) ((T*)(ws + (off)))
#define ROWSS(k) (WSP(float, WS_ROWSS) + (size_t)(k) * M)
#define ROPEC WSP(float, WS_ROPE)
#define ROPES (WSP(float, WS_ROPE) + ROPE_ROWS * 64)
#define TID_LOAD() int tid = tid_k; asm volatile("" : "+v"(tid)); const int lane = tid & 63, wave = __builtin_amdgcn_readfirstlane(tid >> 6); (void)lane; (void)wave
#define GRP_LOAD() const volatile LAS unsigned* const MISCv = (const volatile LAS unsigned*)MISC; const int nl = __builtin_amdgcn_readfirstlane((int)MISCv[12]), ng = __builtin_amdgcn_readfirstlane((int)MISCv[13]), rk = __builtin_amdgcn_readfirstlane((int)MISCv[14]), gi = __builtin_amdgcn_readfirstlane((int)MISCv[15]); \
    const int b0 = gi * NBATCH / ng, b1 = (gi + 1) * NBATCH / ng, t0 = gi * 16 / ng, t1 = (gi + 1) * 16 / ng, d0 = 8 * t0, d1 = 8 * t1; (void)b1; (void)d1; (void)d0; (void)t1; (void)rk; (void)nl
#define LBAR() group_barrier((unsigned*)(ctl + CW_BAR), MISC + 12, tid_k)
#define GEMM_PHASE(EPI, EINIT, Aptr, LDA, Bptr, NN, KK) GEMM_PHASE_H(EPI, EINIT, Aptr, LDA, Bptr, NN, KK, 0, 2, true)
#define GEMM_PHASE_H(EPI, EINIT, Aptr, LDA, Bptr, NN, KK, HH, NH, WHOLE) do { GRP_LOAD(); \
        const int nbw = b1 - b0, hb0 = (WHOLE) ? 0 : (HH) * nbw / (NH), hnb = (WHOLE) ? nbw : ((HH) + 1) * nbw / (NH) - hb0; const bool fine = (WHOLE) || (HH) == 0; \
        pg8::Gemm g{Aptr, Bptr, MP, NN, KK, LDA}; pg8::GroupOrder S{8 * (b0 + hb0), 8 * hnb, (NN) / 256, nl, rk}; pg8::EPI E EINIT; \
        const int nrem = (8 * hnb * ((NN) / 256)) % nl, lo = (nrem && nl > nrem) ? nrem : 0; \
        const bool wide = SG3_WIDE && (NN) >= SG3_MINN && (t1 - t0) == 2;     \
        const int nfine = wide ? ((NN) / 128 + (nl - lo) - 1) / (nl - lo) : ((t1 - t0) * ((NN) / 64) + (nl - lo) - 1) / (nl - lo);     \
        const int nfirst = STG_NFIRST(rk, nfine);     \
        if (fine && rk >= lo) { if (wide) sg3_phase<pg8::EPI, 128, 128>(L + RING_OFF, g.A + (size_t)MP * g.lda, g.Bt, g.N, g.K, E, g.lda, t0, 2, rk - lo, nl - lo, 0, nfirst, tid_k); \
                                else sgemm_phase<pg8::EPI>(L + RING_OFF, g.A + (size_t)MP * g.lda, g.Bt, g.N, g.K, E, g.lda, t0, t1 - t0, rk - lo, nl - lo, 0, nfirst, tid_k); } \
        pg8::gemm_phase<pg8::EPI, pg8::GroupOrder, PG8_ALIGN, PG8_SP2>(L + RING_OFF, g, S, E, tid_k); \
        if (fine && rk >= lo) { if (wide) sg3_phase<pg8::EPI, 128, 128>(L + RING_OFF, g.A + (size_t)MP * g.lda, g.Bt, g.N, g.K, E, g.lda, t0, 2, rk - lo, nl - lo, nfirst, 1 << 20, tid_k); \
                                else sgemm_phase<pg8::EPI>(L + RING_OFF, g.A + (size_t)MP * g.lda, g.Bt, g.N, g.K, E, g.lda, t0, t1 - t0, rk - lo, nl - lo, nfirst, 1 << 20, tid_k); } \
    } while (0)

    {
        TID_LOAD();
        LAS float* scr = (LAS float*)(L + RING_OFF + wave * 16384);
        const int gw = vcu * NWAVES + wave, NGW = G * NWAVES;
        constexpr int I0 = 16 * 96, I1 = 16 * 32, I2 = 16 * 128, I3 = 64 * 32, I4 = 16 * 40, I5 = 16 * 32, I6 = 16 * 128, I7 = 64 * 32, NITEMS = I0 + I1 + I2 + I3 + I4 + I5 + I6 + I7;
        for (int it = gw; it < NITEMS; it += NGW) {
            int r = it;
            if (r < I0) { p0_transpose_item<1>(INP(8), D, NZ, WSP(bf16, WS_WIN), INP(5), scr, r, lane); continue; } r -= I0;
            if (r < I1) { p0_transpose_item<0>(INP(13), D, D, WSP(bf16, WS_WO0), nullptr, scr, r, lane); continue; } r -= I1;
            if (r < I2) { p0_transpose_item<0>(INP(19), D, FF, WSP(bf16, WS_WUP0), INP(6), scr, r, lane); continue; } r -= I2;
            if (r < I3) { p0_transpose_item<0>(INP(20), FF, D, WSP(bf16, WS_WDN0), nullptr, scr, r, lane); continue; } r -= I3;
            if (r < I4) { p0_transpose_item<0>(INP(14), D, NQKV, WSP(bf16, WS_WQKV), INP(5) + D, scr, r, lane); continue; } r -= I4;
            if (r < I5) { p0_transpose_item<0>(INP(17), D, D, WSP(bf16, WS_WO1), nullptr, scr, r, lane); continue; } r -= I5;
            if (r < I6) { p0_transpose_item<0>(INP(19) + (size_t)D * FF, D, FF, WSP(bf16, WS_WUP1), INP(6) + D, scr, r, lane); continue; } r -= I6;
            p0_transpose_item<0>(INP(20) + (size_t)FF * D, FF, D, WSP(bf16, WS_WDN1), nullptr, scr, r, lane);
        }
        for (int m0 = gw; m0 < M; m0 += 2 * NGW) {
            const int m1 = m0 + NGW < M ? m0 + NGW : m0;
            const float* xr0 = m0 < MP ? INP(0) + (size_t)m0 * D : INP(1) + (size_t)(m0 - MP) * D; const float* xr1 = m1 < MP ? INP(0) + (size_t)m1 * D : INP(1) + (size_t)(m1 - MP) * D;
            const GAS f32x4* p0 = (const GAS f32x4*)xr0 + lane; const GAS f32x4* p1 = (const GAS f32x4*)xr1 + lane; f32x4 v[4], w[4]; float s = 0.f, t = 0.f;
#pragma unroll
            for (int j = 0; j < 4; ++j) { v[j] = p0[64 * j]; w[j] = p1[64 * j]; }
#pragma unroll
            for (int j = 0; j < 4; ++j) { s += (v[j].x * v[j].x + v[j].y * v[j].y) + (v[j].z * v[j].z + v[j].w * v[j].w); t += (w[j].x * w[j].x + w[j].y * w[j].y) + (w[j].z * w[j].z + w[j].w * w[j].w); }
            s = wave_sum(s); t = wave_sum(t); if (lane == 0) { ROWSS(0)[m0] = s; ROWSS(0)[m1] = t; }
            GAS unsigned long long* o0 = (GAS unsigned long long*)(WSP(bf16, WS_HB) + (size_t)m0 * D) + lane; GAS unsigned long long* o1 = (GAS unsigned long long*)(WSP(bf16, WS_HB) + (size_t)m1 * D) + lane;
#pragma unroll
            for (int j = 0; j < 4; ++j) { o0[64 * j] = (unsigned long long)pk2(v[j].x, v[j].y) | ((unsigned long long)pk2(v[j].z, v[j].w) << 32); o1[64 * j] = (unsigned long long)pk2(w[j].x, w[j].y) | ((unsigned long long)pk2(w[j].z, w[j].w) << 32); }
        }
        const int gt = vcu * (NWAVES * 64) + tid, NT = G * NWAVES * 64;
        for (int idx = gt; idx < ROPE_ROWS * 64; idx += NT) { const int trow = idx >> 6, j = idx & 63, pos = trow < SEQ ? trow : 16384 + (trow - SEQ); float c, s; rope_entry(pos, j, c, s); ROPEC[idx] = c; ROPES[idx] = s; }
        for (int idx = gt; idx < 4 * 128 * 128; idx += NT) { const int i = (idx >> 7) & 127, j = idx & 127; WSP(bf16, WS_WSB)[idx] = j <= i ? (bf16)f2bf(INP(9)[idx]) : (bf16)0; }
        xcd_barrier(bar);
    }
    if (tid_k == 0) { const unsigned nlx = MISC[8], nx = MISC[9], rkx = MISC[10], gx = MISC[11];
        const unsigned nsub = (nx * NSUB <= 16u && nlx >= NSUB) ? NSUB : 1u, sub = rkx * nsub / nlx, first = (sub * nlx + nsub - 1u) / nsub, nxt = ((sub + 1u) * nlx + nsub - 1u) / nsub;
        MISC[12] = nxt - first; MISC[13] = nx * nsub; MISC[14] = rkx - first; MISC[15] = gx * nsub + sub; MISC[16] = gx * nsub + sub; }
    __syncthreads();
    if (SKEW_TICKS) { GRP_LOAD(); const unsigned long long t_s = __builtin_amdgcn_s_memrealtime(); while (__builtin_amdgcn_s_memrealtime() - t_s < (unsigned long long)(gi * SKEW_TICKS)) __builtin_amdgcn_s_sleep(8); }

    GEMM_PHASE(EpiAB, ({WSP(bf16, WS_Z), ROWSS(0), ROPEC, ROPES}), WSP(bf16, WS_HB), D, WSP(bf16, WS_WIN), NZ, D);
    LBAR();
    {
        TID_LOAD(); GRP_LOAD();
        bf16* const Z = WSP(bf16, WS_Z); bf16* const OC = WSP(bf16, WS_OC); bf16* const SIMG = WSP(bf16, WS_SIMG);
        const int nb = b1 - b0, nstate = 8 * nb;
        for (int uid = rk; uid < nstate; uid += nl) { const int b = b0 + (uid >> 3), h = (uid >> 1) & 3, half = uid & 1;
            ret_state_unit(Z, SIMG, out + OUT_RETP + (size_t)(b * 4 + h) * 16384, b, h, half, L, tid); }
        const bool split = nl > nstate && nl == 2 * nstate && (64 * nb) % nl == 0;
        const int lo2 = nl > nstate ? nstate : 0;
        const bool sfirst = P2MIX && rk >= lo2 && (((rk - lo2) >> P2MIX_SH) & 1);
#pragma unroll 1
        for (int pass = 0; pass < 2; ++pass) {
          if ((pass == 0) != sfirst) {
            for (int it = 0; ; ++it) { int uid;
                if (split) { const int per = 64 * nb / nl * 2, ks = rk < nstate ? P2_KS : 8 - P2_KS, base = (rk < nstate ? rk : rk - nstate) * per + (rk < nstate ? 0 : P2_KS * per / 8); if (it >= ks * per / 8) break; uid = base + it; }
                else { uid = rk + it * nl; if (uid >= 64 * nb) break; }
                const int b = b0 + (uid >> 6), n = (uid >> 2) & 15, g = uid & 3;
                gm_unit_mfma(Z, OC, WSP(bf16, WS_WSB), INP(10), INP(11), INP(12), (size_t)b * SEQ + n * 128, g, L, tid); }
          } else {
            if (rk >= lo2) for (int su = rk - lo2; su < 4 * (d1 - d0); su += nl - lo2) { const int db = d0 + (su >> 2), h = su & 3;
                sample_unit(Z, OC, db, h, INP(2) + (size_t)(db * 4 + h) * 16384, out + OUT_RETS + (size_t)(db * 4 + h) * 16384, out + OUT_GMS + (size_t)db * 8 * 512, INP(9), INP(10), INP(11), INP(12), sm, tid); }
          }
        }
        LBAR();
        ret_out_phase(Z, OC, SIMG, b0, nb, rk, nl, L, tid);
    }
    LBAR();
    GEMM_PHASE(EpiRes, ({WSP(bf16, WS_HB), ROWSS(1), nullptr}), WSP(bf16, WS_OC), BP, WSP(bf16, WS_WO0), D, D);
    LBAR();
    GEMM_PHASE(EpiUp, ({WSP(bf16, WS_BIG), ROWSS(1)}), WSP(bf16, WS_HB), D, WSP(bf16, WS_WUP0), FF, D);
    LBAR();
    GEMM_PHASE(EpiRes, ({WSP(bf16, WS_HB), ROWSS(2), nullptr}), WSP(bf16, WS_BIG), BP, WSP(bf16, WS_WDN0), D, FF);
    LBAR();
    GEMM_PHASE(EpiQKV, ({WSP(bf16, WS_QKV), ROWSS(2), INP(15), out + OUT_CKP, out + OUT_CKS}), WSP(bf16, WS_HB), D, WSP(bf16, WS_WQKV), NQKV, D);
    {
        TID_LOAD(); GRP_LOAD();
        const int nrem6 = (8 * (b1 - b0) * (NQKV / 256)) % nl, lo6 = (nrem6 && nl > nrem6) ? nrem6 : 0;
        if (rk >= lo6) { const int ndb = d1 - d0, nmine = 2 * ndb * 3840, NTq = (nl - lo6) * NWAVES * 64;
            for (int i0 = (rk - lo6) * NWAVES * 64 + tid; i0 < nmine; i0 += 4 * NTq) { f32x4 cv[4];
#pragma unroll
                for (int u = 0; u < 4; ++u) { const int idx = i0 + u * NTq; if (idx < nmine) { const int which = idx / (ndb * 3840), rem = idx % (ndb * 3840), db = d0 + rem / 3840, o4 = rem % 3840;
                    cv[u] = *((const f32x4*)((which ? INP(4) : INP(3)) + (size_t)db * 16384 + 1024) + o4); } }
#pragma unroll
                for (int u = 0; u < 4; ++u) { const int idx = i0 + u * NTq; if (idx < nmine) { const int which = idx / (ndb * 3840), rem = idx % (ndb * 3840), db = d0 + rem / 3840, o4 = rem % 3840;
                    *((f32x4*)(out + (which ? OUT_CVS : OUT_CKS) + (size_t)db * 16384) + o4) = cv[u]; } } } }
    }
    LBAR();
    {
        TID_LOAD(); GRP_LOAD();
        bf16* const QKV = WSP(bf16, WS_QKV); bf16* const AO = WSP(bf16, WS_AO); const float* const swa_sinks = INP(16); const float* const cache_k = INP(3); const float* const cache_v = INP(4);
        const int c = lane & 15, np = 32 * (b1 - b0), ns = 2 * (d1 - d0);
        for (int uid = rk; uid < np + ns; uid += nl) {
            if (uid < np) { const int b = b0 + (uid >> 5), n = (uid >> 1) & 15, kvh = uid & 1;
#pragma unroll
                for (int i = 0; i < 4; ++i) { const int idx = tid + 512 * i, row = idx >> 3, ch = idx & 7, tok = n * 128 - 128 + row; v4u kk = (v4u){0u, 0u, 0u, 0u}, vv = kk;
                    if (tok >= 0) { const bf16* src = QKV + (size_t)(b * SEQ + tok) * BP + 1024 + kvh * 64 + ch * 8; kk = *(const v4u*)src; vv = *(const v4u*)(src + 128); }
                    *(LAS v4u*)(L + A_K + row * A_KST + ch * 16) = kk; *(LAS v4u*)(L + A_V + row * A_KST + ch * 16) = vv; }
                __syncthreads();
                { const int head = kvh * 8 + wave; const float sink2 = swa_sinks[head] * LOG2E; const int g8 = 8 * (lane >> 4);
                  const bf16* qb = QKV + (size_t)(b * SEQ + n * 128 + c) * BP + head * 64 + g8;
                  bf16x8 qc0 = *(const bf16x8*)qb, qc1 = *(const bf16x8*)(qb + 32);
#pragma unroll 1
                  for (int qt = 0; qt < 8; ++qt) { const size_t row = (size_t)(b * SEQ + n * 128 + 16 * qt + c);
                      const bf16* qn = qb + (size_t)(qt < 7 ? 16 * (qt + 1) : 0) * BP; const bf16x8 qn0 = *(const bf16x8*)qn, qn1 = *(const bf16x8*)(qn + 32);
                      if (n > 0) attn_tile_mfma<true>(qc0, qc1, AO + row * BP + head * 64, 16 * qt + c, sink2, qt >> 1, 0, qt & 1, L, lane);
                      else attn_tile_mfma<false>(qc0, qc1, AO + row * BP + head * 64, 16 * qt + c, sink2, qt >> 1, 128, 0, L, lane);
                      qc0 = qn0; qc1 = qn1; } }
                __syncthreads();
            } else { const int su = uid - np, db = d0 + (su >> 1), kvh = su & 1;
                for (int idx = tid; idx < 160 * 8; idx += 512) { const int row = idx >> 3, ch = idx & 7; v4u kk = (v4u){0u, 0u, 0u, 0u}, vv = kk;
                    if (row < 128) { const float* sk_ = cache_k + (size_t)(db * 128 + row) * 128 + kvh * 64 + ch * 8; const float* sv_ = cache_v + (size_t)(db * 128 + row) * 128 + kvh * 64 + ch * 8;
                        const f32x4 k0 = *(const f32x4*)sk_, k1 = *(const f32x4*)(sk_ + 4), v0 = *(const f32x4*)sv_, v1 = *(const f32x4*)(sv_ + 4);
                        kk = (v4u){pk2(k0[0], k0[1]), pk2(k0[2], k0[3]), pk2(k1[0], k1[1]), pk2(k1[2], k1[3])}; vv = (v4u){pk2(v0[0], v0[1]), pk2(v0[2], v0[3]), pk2(v1[0], v1[1]), pk2(v1[2], v1[3])}; }
                    else if (row < 136) { const bf16* src = QKV + (size_t)(MP + db * 8 + row - 128) * BP + 1024 + kvh * 64 + ch * 8; kk = *(const v4u*)src; vv = *(const v4u*)(src + 128); }
                    *(LAS v4u*)(L + A_K + row * A_KST + ch * 16) = kk; *(LAS v4u*)(L + A_V + row * A_KST + ch * 16) = vv; }
                __syncthreads();
                if (wave < 4) { const int rho = 16 * wave + c, head = kvh * 8 + (rho >> 3), i = rho & 7; const size_t row = (size_t)(MP + db * 8 + i);
                    const bf16* qp = QKV + row * BP + head * 64 + 8 * (lane >> 4);
                    attn_tile_mfma<false>(*(const bf16x8*)qp, *(const bf16x8*)(qp + 32), AO + row * BP + head * 64, i, swa_sinks[head] * LOG2E, 0, 0, 0, L, lane); }
                __syncthreads();
            }
        }
    }
    LBAR();
    GEMM_PHASE(EpiRes, ({WSP(bf16, WS_HB), ROWSS(3), INP(18)}), WSP(bf16, WS_AO), BP, WSP(bf16, WS_WO1), D, D);
    LBAR();
    GEMM_PHASE(EpiUp, ({WSP(bf16, WS_BIG), ROWSS(3)}), WSP(bf16, WS_HB), D, WSP(bf16, WS_WUP1), FF, D);
    LBAR();
    bool fusefin;
    { GRP_LOAD(); fusefin = FUSE_FIN && nl == 32 && (b1 - b0) * 8 * (D / 256) == 2 * nl; }
    if (fusefin) { GRP_LOAD();
        pg8::Gemm g{WSP(bf16, WS_BIG), WSP(bf16, WS_WDN1), MP, D, FF, BP}; pg8::GroupOrder S{8 * b0, 8 * (b1 - b0), D / 256, nl, rk};
        pg8::EpiResFin EF{WSP(bf16, WS_HB), ROWSS(4), (unsigned*)(ctl + CW_FIN), INP(7), out, (unsigned*)(ctl + CW_BAR) + XB_TMO};
        pg8::EpiRes E{WSP(bf16, WS_HB), ROWSS(4), nullptr};
        const int nfine = ((t1 - t0) * (D / 64) + nl - 1) / nl, nfirst = STG_NFIRST(rk, nfine);
        sgemm_phase<pg8::EpiRes>(L + RING_OFF, g.A + (size_t)MP * g.lda, g.Bt, g.N, g.K, E, g.lda, t0, t1 - t0, rk, nl, 0, nfirst, tid_k);
        pg8::gemm_phase<pg8::EpiResFin, pg8::GroupOrder, PG8_ALIGN, PG8_SP2>(L + RING_OFF, g, S, EF, tid_k);
        sgemm_phase<pg8::EpiRes>(L + RING_OFF, g.A + (size_t)MP * g.lda, g.Bt, g.N, g.K, E, g.lda, t0, t1 - t0, rk, nl, nfirst, 1 << 20, tid_k);
    } else {
        GEMM_PHASE(EpiRes, ({WSP(bf16, WS_HB), ROWSS(4), nullptr}), WSP(bf16, WS_BIG), BP, WSP(bf16, WS_WDN1), D, FF);
    }
    LBAR();
    {
        TID_LOAD(); GRP_LOAD();
        const float* rs4 = ROWSS(4); const float* const norm_final = INP(7);
        const int np = fusefin ? 0 : SEQ * (b1 - b0), ns = 8 * (d1 - d0);
        for (int i = rk * NWAVES + wave; i < np + ns; i += nl * NWAVES) {
            const int m = i < np ? b0 * SEQ + i : MP + 8 * d0 + (i - np);
            const float rstd = 1.0f / sqrtf(rs4[m] * (1.0f / 1024.0f) + 1e-6f);
            GAS f32x4* yr = (GAS f32x4*)(out + (size_t)m * D) + lane; const GAS f32x4* gr = (const GAS f32x4*)norm_final + lane;
            const GAS unsigned long long* h8 = (const GAS unsigned long long*)(WSP(bf16, WS_HB) + (size_t)m * D) + lane;
#pragma unroll
            for (int j = 0; j < 4; ++j) { const unsigned long long hw = h8[64 * j]; const unsigned lo = (unsigned)hw, hi = (unsigned)(hw >> 32);
                const f32x4 hv = (f32x4){__uint_as_float(lo << 16), __uint_as_float(lo & 0xffff0000u), __uint_as_float(hi << 16), __uint_as_float(hi & 0xffff0000u)};
                yr[64 * j] = hv * rstd * gr[64 * j]; }
        }
    }
}

extern "C" void kernel_launch(void* const* d_in, const int* in_sizes, int n_in, void* d_out, int out_size, void* d_ws, size_t ws_size, hipStream_t stream) {
    static int grid = 0;
    if (grid == 0) {
        if (n_in != 21 || in_sizes[0] != MP * D || (size_t)out_size != OUT_END || ws_size < WS_END) { fprintf(stderr, "kernel_launch: unexpected shapes (n_in %d, in0 %d, out %d, ws %zu); nothing launched\n", n_in, n_in > 0 ? in_sizes[0] : -1, out_size, ws_size); grid = -1; return; }
        int dev = 0, cus = 0, per_cu = 0;
        if (hipGetDevice(&dev) != hipSuccess || hipDeviceGetAttribute(&cus, hipDeviceAttributeMultiprocessorCount, dev) != hipSuccess) { fprintf(stderr, "kernel_launch: device query failed\n"); grid = -1; return; }
        if (hipFuncSetAttribute((const void*)fwd_kernel, hipFuncAttributeMaxDynamicSharedMemorySize, LDS_BYTES) != hipSuccess) { fprintf(stderr, "kernel_launch: hipFuncSetAttribute failed\n"); grid = -1; return; }
        if (hipOccupancyMaxActiveBlocksPerMultiprocessor(&per_cu, (const void*)fwd_kernel, NWAVES * 64, LDS_BYTES) != hipSuccess || per_cu < 1) fprintf(stderr, "kernel_launch: note: occupancy query reports %d workgroups per CU\n", per_cu);
        (void)hipGetLastError();
        grid = cus;
    }
    if (grid < 0) return;
    if (hipMemsetAsync((char*)d_ws + WS_CTL, 0, CTL_ZERO_BYTES, stream) != hipSuccess) { fprintf(stderr, "kernel_launch: hipMemsetAsync failed\n"); return; }
    Args a{};
    for (int i = 0; i < 21; ++i) a.in[i] = (const float*)d_in[i];
    a.out = (float*)d_out; a.ws = (unsigned char*)d_ws;
    hipLaunchKernelGGL(fwd_kernel, dim3(grid), dim3(NWAVES * 64), LDS_BYTES, stream, a);
    const hipError_t le = hipPeekAtLastError();
    if (le != hipSuccess) fprintf(stderr, "kernel_launch: launch failed: %s\n", hipGetErrorName(le));
}
```
